# Optimizing an MI355X kernel written in HIP

```python
import jax, jax.numpy as jnp
from jax import lax
import numpy as np

D_MODEL = 2048
BATCH = 8
SEQ = 2048
DEPTH = 1

MIX_WIDTH = D_MODEL
HEAD_DIM = 128
ATTN_WIDTH = MIX_WIDTH // 2
ATTN_HEADS = ATTN_WIDTH // HEAD_DIM
GMLP_GROUP_DIM = 128
GMLP_WIDTH = MIX_WIDTH - ATTN_WIDTH
GMLP_GROUPS = GMLP_WIDTH // GMLP_GROUP_DIM
CHUNK = 128
Q_BLOCK = 128
D_FF = 4 * D_MODEL
N_MOD = 6
IN_COLS = 3 * ATTN_WIDTH + ATTN_HEADS + 2 * GMLP_WIDTH
EPS = 1e-6

kernel_name = "hybrid_fox_gmlp_adaln_block"


def rms_norm(x, g):
    xf = x.astype(jnp.float32)
    y = xf * lax.rsqrt(jnp.mean(xf * xf, axis=-1, keepdims=True) + EPS)
    return (y * g.astype(jnp.float32)).astype(x.dtype)


def layer_norm_nobias(x, g):
    xf = x.astype(jnp.float32)
    mu = jnp.mean(xf, axis=-1, keepdims=True)
    xc = xf - mu
    y = xc * lax.rsqrt(jnp.mean(xc * xc, axis=-1, keepdims=True) + EPS)
    return y * g.astype(jnp.float32)


def modulate(h, shift, scale):
    return h * (1.0 + scale[:, None, :]) + shift[:, None, :]


def forgetting_attention(q, k, v, f_logit):
    B, S, H, Dh = q.shape
    nblk = S // Q_BLOCK
    scale = 1.0 / np.sqrt(Dh).astype(np.float32)
    F = jnp.cumsum(jax.nn.log_sigmoid(f_logit.astype(jnp.float32)), axis=1)
    F_bhs = F.transpose(0, 2, 1)
    kf = k.astype(jnp.float32)
    vf = v.astype(jnp.float32)
    qb = q.astype(jnp.float32).reshape(B, nblk, Q_BLOCK, H, Dh).transpose(1, 0, 3, 2, 4)
    Fq = F_bhs.reshape(B, H, nblk, Q_BLOCK).transpose(2, 0, 1, 3)
    kpos = jnp.arange(S)

    def block(args):
        i, q_blk, F_blk = args
        s = jnp.einsum('bhqd,bshd->bhqs', q_blk, kf) * scale
        s = s + F_blk[..., None] - F_bhs[:, :, None, :]
        qpos = i * Q_BLOCK + jnp.arange(Q_BLOCK)
        causal = kpos[None, :] <= qpos[:, None]
        s = jnp.where(causal[None, None], s, -jnp.inf)
        p = jax.nn.softmax(s, axis=-1)
        return jnp.einsum('bhqs,bshd->bqhd', p, vf)

    out = lax.map(block, (jnp.arange(nblk), qb, Fq))
    return out.transpose(1, 0, 2, 3, 4).reshape(B, S, H * Dh)


def chunked_spatial_gating(u, v, g_ln, w_s, b_s):
    B, S, G, C = v.shape
    n = S // CHUNK
    vn = layer_norm_nobias(v, g_ln)
    vc = vn.reshape(B, n, CHUNK, G, C)
    mask = jnp.tril(jnp.ones((CHUNK, CHUNK), dtype=jnp.float32))
    w = w_s.astype(jnp.float32) * mask[None]
    z = jnp.einsum('gts,bnsgc->bntgc', w, vc) + b_s.astype(jnp.float32).T[None, None, :, :, None]
    out = u.astype(jnp.float32) * z.reshape(B, S, G, C)
    return out.reshape(B, S, G * C)


def setup_inputs(seed: int = 0) -> dict:
    key = jax.random.key(seed)
    ks = jax.random.split(key, 20)
    f32 = jnp.float32
    nrm = lambda k, shp, s: jax.random.normal(k, shp, f32) * s
    gain = lambda k, shp: 1.0 + 0.02 * jax.random.normal(k, shp, f32)
    x = jax.random.normal(ks[0], (BATCH, SEQ, D_MODEL), f32)
    c = jax.random.normal(ks[1], (BATCH, D_MODEL), f32)
    w_ada = nrm(ks[2], (DEPTH, D_MODEL, N_MOD * D_MODEL), 0.5 * D_MODEL ** -0.5)
    b_ada = nrm(ks[3], (DEPTH, N_MOD * D_MODEL), 0.02)
    g_mix = gain(ks[4], (DEPTH, D_MODEL))
    w_in = nrm(ks[5], (DEPTH, D_MODEL, IN_COLS), D_MODEL ** -0.5)
    b_f = jax.random.uniform(ks[6], (DEPTH, ATTN_HEADS), f32, 1.0, 4.0)
    g_q = gain(ks[7], (DEPTH, HEAD_DIM))
    g_k = gain(ks[8], (DEPTH, HEAD_DIM))
    g_sgu = gain(ks[9], (DEPTH, GMLP_GROUPS, GMLP_GROUP_DIM))
    w_s = nrm(ks[10], (DEPTH, GMLP_GROUPS, CHUNK, CHUNK), 0.5 * CHUNK ** -0.5)
    b_s = 1.0 + nrm(ks[11], (DEPTH, GMLP_GROUPS, CHUNK), 0.1)
    w_out = nrm(ks[12], (DEPTH, MIX_WIDTH, D_MODEL), MIX_WIDTH ** -0.5)
    g_ffn = gain(ks[13], (DEPTH, D_MODEL))
    w_ff1 = nrm(ks[14], (DEPTH, D_MODEL, D_FF), D_MODEL ** -0.5)
    w_ff2 = nrm(ks[15], (DEPTH, D_FF, D_MODEL), D_FF ** -0.5)
    return {"x": x, "c": c, "w_ada": w_ada, "b_ada": b_ada, "g_mix": g_mix, "w_in": w_in,
            "b_f": b_f, "g_q": g_q, "g_k": g_k, "g_sgu": g_sgu, "w_s": w_s, "b_s": b_s,
            "w_out": w_out, "g_ffn": g_ffn, "w_ff1": w_ff1, "w_ff2": w_ff2}


def reference(x, c, w_ada, b_ada, g_mix, w_in, b_f, g_q, g_k, g_sgu, w_s, b_s,
              w_out, g_ffn, w_ff1, w_ff2):
    B, S, D = x.shape
    H, Dh, G, C = ATTN_HEADS, HEAD_DIM, GMLP_GROUPS, GMLP_GROUP_DIM
    c_act = jax.nn.silu(c)
    for l in range(DEPTH):
        mod = c_act @ w_ada[l] + b_ada[l]
        shift1, scale1, gate1, shift2, scale2, gate2 = jnp.split(mod, N_MOD, axis=-1)

        h = modulate(rms_norm(x, g_mix[l]), shift1, scale1)
        proj = h @ w_in[l]
        o = 0
        q = proj[..., o:o + ATTN_WIDTH]; o += ATTN_WIDTH
        k = proj[..., o:o + ATTN_WIDTH]; o += ATTN_WIDTH
        v = proj[..., o:o + ATTN_WIDTH]; o += ATTN_WIDTH
        f_logit = proj[..., o:o + H]; o += H
        u_g = proj[..., o:o + GMLP_WIDTH]; o += GMLP_WIDTH
        v_g = proj[..., o:o + GMLP_WIDTH]

        q = rms_norm(q.reshape(B, S, H, Dh), g_q[l])
        k = rms_norm(k.reshape(B, S, H, Dh), g_k[l])
        v = v.reshape(B, S, H, Dh)
        attn = forgetting_attention(q, k, v, f_logit + b_f[l]).astype(x.dtype)

        u_g = jax.nn.gelu(u_g).reshape(B, S, G, C)
        v_g = jax.nn.gelu(v_g).reshape(B, S, G, C)
        sgu = chunked_spatial_gating(u_g, v_g, g_sgu[l], w_s[l], b_s[l]).astype(x.dtype)

        mix = jnp.concatenate([attn, sgu], axis=-1) @ w_out[l]
        x = x + gate1[:, None, :] * mix

        h2 = modulate(rms_norm(x, g_ffn[l]), shift2, scale2)
        ff = jnp.square(jax.nn.relu(h2 @ w_ff1[l])) @ w_ff2[l]
        x = x + gate2[:, None, :] * ff
    return x
```

```cpp
#include <hip/hip_runtime.h>
#include <hip/hip_bf16.h>
#include <hip/hip_cooperative_groups.h>
#include <cstdio>
#include <cstdint>
#include <cmath>
namespace cg = cooperative_groups;
namespace pg8 {
#define PG8_LAS __attribute__((address_space(3)))
typedef unsigned short bf16_t;
typedef short bf16x8 __attribute__((ext_vector_type(8)));
typedef float f32x4 __attribute__((ext_vector_type(4)));
typedef unsigned u32x4 __attribute__((ext_vector_type(4)));
constexpr int BM = 256, BK = 64, HALF = 128, HTB = HALF * BK * 2  , STAGE_BYTES = 8 * HTB, NXCD = 8, WGM = 8;

__host__ __device__ __forceinline__ int lds_byte(int r, int c) { const int st = (r >> 4) * 2 + (c >> 5), rr = r & 15, cc = c & 31, ob = rr * 64 + cc * 2; return st * 1024 + (ob ^ (((ob >> 9) & 1) << 5)); }
__host__ __device__ __forceinline__ void stage_rc(int b, int& R, int& C) { const int st = b / 1024, sb = b % 1024, swz = sb ^ (((sb >> 9) & 1) << 5); R = (st >> 1) * 16 + swz / 64; C = (st & 1) * 32 + (swz % 64) / 2; }
__host__ __device__ __forceinline__ int perm32(int rho) { const int n = rho >> 4, i = rho & 15; return 8 * (i >> 2) + 4 * n + (i & 3); }

struct Unit { int pm, pn; };
struct Gemm { const bf16_t* A; const bf16_t* Bt; int M, N, K; };

struct StaticOrder {
    int nM, nN, nwg, G, c;
    __host__ __device__ void init(int M, int N, int G_, int c_) { nM = M / BM; nN = N / BM; nwg = nM * nN; G = G_; c = c_; }
    __host__ __device__ bool next(int i, Unit& u) const {
        const long L = (long)i * G + c; if (L >= nwg) return false;
        int wgid = (int)L; { const int q = nwg / NXCD, r = nwg % NXCD, xcd = wgid % NXCD, off = wgid / NXCD; wgid = (xcd < r ? xcd * (q + 1) : r * (q + 1) + (xcd - r) * q) + off; }
        const int nig = WGM * nN, gid = wgid / nig, fm = gid * WGM, gsz = (nM - fm) < WGM ? (nM - fm) : WGM;
        u.pm = fm + ((wgid % nig) % gsz); u.pn = (wgid % nig) / gsz; return true;
    }
    __device__ __forceinline__ void a_ready(const Unit&) const {}
    __device__ __forceinline__ void done(const Unit&) const {}
};

__device__ __forceinline__ unsigned cvt_pk_bf16(float lo, float hi) { unsigned r; asm volatile("v_cvt_pk_bf16_f32 %0, %1, %2" : "=v"(r) : "v"(lo), "v"(hi)); return r; }
typedef float f32x2 __attribute__((ext_vector_type(2)));
__device__ __forceinline__ float gelu_tanh(float x) { const float u = x * (0.7978845608f + 0.0356774081f * x * x); return x * __builtin_amdgcn_rcpf(1.f + __builtin_amdgcn_exp2f(-2.885390082f * u)); }
struct EpiProj {
    static constexpr bool PERM = true, AFTER_DRAIN = false;
    bf16_t* O; int ldc; int act_from;
    __device__ __forceinline__ void operator()(const f32x4 (&acc)[2][2][4][2], const Unit& u, int wr, int wc, int fr, int fq) const {
        const int row0 = u.pm * BM + wr * 64 + fr, col0 = u.pn * BM + wc * 32 + 8 * fq; const bool act = u.pn >= act_from;
#pragma unroll
        for (int ai = 0; ai < 2; ++ai)
#pragma unroll
            for (int m = 0; m < 4; ++m) { bf16_t* rowp = O + (size_t)(row0 + ai * HALF + m * 16) * ldc + col0;
#pragma unroll
                for (int bj = 0; bj < 2; ++bj) { f32x4 v0 = acc[ai][bj][m][0], v1 = acc[ai][bj][m][1];
                    if (act) {
#pragma unroll
                        for (int e = 0; e < 4; ++e) { v0[e] = gelu_tanh(v0[e]); v1[e] = gelu_tanh(v1[e]); } }
                    u32x4 w; w.x = cvt_pk_bf16(v0[0], v0[1]); w.y = cvt_pk_bf16(v0[2], v0[3]); w.z = cvt_pk_bf16(v1[0], v1[1]); w.w = cvt_pk_bf16(v1[2], v1[3]);
                    *(u32x4*)(rowp + bj * HALF) = w; } }
    }
};
struct EpiRelu2 {
    static constexpr bool PERM = true, AFTER_DRAIN = false;
    bf16_t* O; int ldc;
    __device__ __forceinline__ void operator()(const f32x4 (&acc)[2][2][4][2], const Unit& u, int wr, int wc, int fr, int fq) const {
        const int row0 = u.pm * BM + wr * 64 + fr, col0 = u.pn * BM + wc * 32 + 8 * fq;
#pragma unroll
        for (int ai = 0; ai < 2; ++ai)
#pragma unroll
            for (int m = 0; m < 4; ++m) { bf16_t* rowp = O + (size_t)(row0 + ai * HALF + m * 16) * ldc + col0;
#pragma unroll
                for (int bj = 0; bj < 2; ++bj) { f32x4 v0 = acc[ai][bj][m][0], v1 = acc[ai][bj][m][1];
#pragma unroll
                    for (int e = 0; e < 4; ++e) { const float a0 = fmaxf(v0[e], 0.f), a1 = fmaxf(v1[e], 0.f); v0[e] = a0 * a0; v1[e] = a1 * a1; }
                    u32x4 w; w.x = cvt_pk_bf16(v0[0], v0[1]); w.y = cvt_pk_bf16(v0[2], v0[3]); w.z = cvt_pk_bf16(v1[0], v1[1]); w.w = cvt_pk_bf16(v1[2], v1[3]);
                    *(u32x4*)(rowp + bj * HALF) = w; } }
    }
};
struct EpiRes {
    static constexpr bool PERM = false, AFTER_DRAIN = false;
    const float* base; float* out; int ldc; const float* gate; int gstride;
    __device__ __forceinline__ void operator()(const f32x4 (&acc)[2][2][4][2], const Unit& u, int wr, int wc, int fr, int fq) const {
        const int row0 = u.pm * BM + wr * 64 + fr, col0 = u.pn * BM + wc * 32 + 4 * fq;
        const float* gp = gate + (size_t)(u.pm >> 3) * gstride + col0;
        f32x4 gv[2][2];
#pragma unroll
        for (int bj = 0; bj < 2; ++bj)
#pragma unroll
            for (int n = 0; n < 2; ++n) gv[bj][n] = *(const f32x4*)(gp + bj * HALF + n * 16);
#pragma unroll
        for (int ai = 0; ai < 2; ++ai)
#pragma unroll
            for (int m = 0; m < 4; ++m) { const size_t off = (size_t)(row0 + ai * HALF + m * 16) * ldc + col0;
#pragma unroll
                for (int bj = 0; bj < 2; ++bj)
#pragma unroll
                    for (int n = 0; n < 2; ++n) { const f32x4 bs = *(const f32x4*)(base + off + bj * HALF + n * 16);
                        *(f32x4*)(out + off + bj * HALF + n * 16) = bs + gv[bj][n] * acc[ai][bj][m][n]; }
                if (m & 1) asm volatile("" ::: "memory"); }
    }
};
template <class Epi, class Sched, bool ALIGN_EPI = false, bool SP2 = false>
__device__ __forceinline__ void gemm_phase(PG8_LAS unsigned char* lds, const Gemm g, const Sched& S, const Epi& E) {
    const int tid = threadIdx.x, wid = __builtin_amdgcn_readfirstlane(tid >> 6), lane = tid & 63, wr = wid >> 2, wc = wid & 3, fr = lane & 15, fq = lane >> 4;
    const int K = g.K, nt = K / BK;
    unsigned voffA[2], voffB[2];
#pragma unroll
    for (int i = 0; i < 2; ++i) { int R, C; stage_rc(tid * 16 + i * 8192, R, C); const int Rb = Epi::PERM ? ((R & ~31) + perm32(R & 31)) : R;
        voffA[i] = (unsigned)(R * K + C) * 2u; voffB[i] = (unsigned)(Rb * K + C) * 2u; }
    const size_t kstep = (size_t)(BK * 2);
    const size_t hstep = (size_t)HALF * K * 2;
    const size_t tstep = 2 * hstep;
    const unsigned ldsw = (unsigned)wid * 1024u;
    const int aoff = lds_byte(wr * 64 + fr, fq * 8), boff = lds_byte(wc * 32 + fr, fq * 8);
#define PG8_SA(b, h) (((b) * 2 + (h)) * HTB)
#define PG8_SB(b, h) ((4 + (b) * 2 + (h)) * HTB)
#define PG8_STAGE(bufoff, gbase, voff) do { _Pragma("unroll") for (int _i = 0; _i < 2; ++_i) \
        __builtin_amdgcn_global_load_lds((const unsigned*)((const char*)(gbase) + (voff)[_i]), (PG8_LAS unsigned*)(lds + (bufoff) + ldsw + _i * 8192), 16, 0, 0); } while (0)
#define PG8_LDA(dst, b, h) do { _Pragma("unroll") for (int m = 0; m < 4; ++m) _Pragma("unroll") for (int k = 0; k < 2; ++k) dst[m][k] = *(const PG8_LAS bf16x8*)(lds + PG8_SA(b, h) + aoff + m * 2048 + k * 1024); } while (0)
#define PG8_LDB(dst, b, h) do { _Pragma("unroll") for (int n = 0; n < 2; ++n) _Pragma("unroll") for (int k = 0; k < 2; ++k) dst[n][k] = *(const PG8_LAS bf16x8*)(lds + PG8_SB(b, h) + boff + n * 2048 + k * 1024); } while (0)
#define PG8_MMA(ai, bj, At, Bt) do { __builtin_amdgcn_s_setprio(1); _Pragma("unroll") for (int m = 0; m < 4; ++m) _Pragma("unroll") for (int n = 0; n < 2; ++n) _Pragma("unroll") for (int k = 0; k < 2; ++k) \
        acc[ai][bj][m][n] = __builtin_amdgcn_mfma_f32_16x16x32_bf16(Bt[n][k], At[m][k], acc[ai][bj][m][n], 0, 0, 0); __builtin_amdgcn_s_setprio(0); } while (0)
#define PG8_WAIT_V(n) asm volatile("s_waitcnt vmcnt(" #n ")" ::: "memory")
#define PG8_WAIT_L(n) asm volatile("s_waitcnt lgkmcnt(" #n ")" ::: "memory")
#define PG8_BAR __builtin_amdgcn_s_barrier()
#define PG8_SCHED __builtin_amdgcn_sched_barrier(0)
    Unit cur, nxt; int ui = 0;
    if (!S.next(0, cur)) return;
    f32x4 acc[2][2][4][2];
#pragma unroll
    for (int a = 0; a < 2; ++a)
#pragma unroll
        for (int b = 0; b < 2; ++b)
#pragma unroll
            for (int m = 0; m < 4; ++m)
#pragma unroll
                for (int n = 0; n < 2; ++n) acc[a][b][m][n] = (f32x4){0.f, 0.f, 0.f, 0.f};
    bf16x8 At[4][2], B0[2][2], B1[2][2];
    const char* cA = (const char*)g.A + (size_t)cur.pm * tstep; const char* cB = (const char*)g.Bt + (size_t)cur.pn * tstep;
    S.a_ready(cur);
    if constexpr (SP2) {
        PG8_STAGE(PG8_SB(0, 0), cB, voffB); PG8_STAGE(PG8_SB(0, 1), cB + hstep, voffB); PG8_STAGE(PG8_SA(0, 0), cA, voffA); PG8_STAGE(PG8_SA(0, 1), cA + hstep, voffA);
        if (wr == 1) PG8_BAR;
        PG8_WAIT_V(2); PG8_BAR;
        PG8_STAGE(PG8_SB(1, 0), cB + kstep, voffB); PG8_STAGE(PG8_SA(1, 0), cA + kstep, voffA); PG8_STAGE(PG8_SB(1, 1), cB + hstep + kstep, voffB);
        PG8_WAIT_V(6); PG8_BAR;
    } else {
        PG8_STAGE(PG8_SB(0, 0), cB, voffB); PG8_STAGE(PG8_SA(0, 0), cA, voffA); PG8_STAGE(PG8_SB(0, 1), cB + hstep, voffB); PG8_STAGE(PG8_SA(0, 1), cA + hstep, voffA);
        if (wr == 1) PG8_BAR;
        PG8_WAIT_V(4); PG8_BAR;
        PG8_STAGE(PG8_SB(1, 0), cB + kstep, voffB); PG8_STAGE(PG8_SA(1, 0), cA + kstep, voffA); PG8_STAGE(PG8_SB(1, 1), cB + hstep + kstep, voffB);
        PG8_WAIT_V(6); PG8_BAR;
    }
    for (;;) {
        const bool has_next = S.next(ui + 1, nxt);
        const char* nA = has_next ? (const char*)g.A + (size_t)nxt.pm * tstep : cA; const char* nB = has_next ? (const char*)g.Bt + (size_t)nxt.pn * tstep : cB;
        for (int t = 0; t < nt; t += 2) {
            const bool last = (t == nt - 2);
            const char* a1 = cA + (size_t)(t + 1) * kstep;
            const char* a2 = last ? nA : cA + (size_t)(t + 2) * kstep; const char* b2 = last ? nB : cB + (size_t)(t + 2) * kstep;
            const char* a3 = a2 + kstep; const char* b3 = b2 + kstep;
            if (last && has_next) S.a_ready(nxt);
            if constexpr (SP2) {
            PG8_LDB(B0, 0, 0); PG8_LDB(B1, 0, 1); PG8_SCHED; PG8_LDA(At, 0, 0); PG8_STAGE(PG8_SA(1, 1), a1 + hstep, voffA);
            PG8_WAIT_V(8); PG8_WAIT_L(0); PG8_BAR; PG8_MMA(0, 0, At, B0); PG8_MMA(0, 1, At, B1); PG8_BAR; PG8_SCHED;
            PG8_LDA(At, 0, 1); PG8_STAGE(PG8_SB(0, 0), b2, voffB); PG8_STAGE(PG8_SB(0, 1), b2 + hstep, voffB); PG8_STAGE(PG8_SA(0, 0), a2, voffA);
            PG8_WAIT_V(8); PG8_WAIT_L(0); PG8_BAR; PG8_MMA(1, 0, At, B0); PG8_MMA(1, 1, At, B1); PG8_BAR; PG8_SCHED;
            PG8_LDB(B0, 1, 0); PG8_LDB(B1, 1, 1); PG8_SCHED; PG8_LDA(At, 1, 0); PG8_STAGE(PG8_SA(0, 1), a2 + hstep, voffA);
            PG8_WAIT_V(8); PG8_WAIT_L(0); PG8_BAR; PG8_MMA(0, 0, At, B0); PG8_MMA(0, 1, At, B1); PG8_BAR; PG8_SCHED;
            PG8_LDA(At, 1, 1); PG8_STAGE(PG8_SB(1, 0), b3, voffB); PG8_STAGE(PG8_SB(1, 1), b3 + hstep, voffB); PG8_STAGE(PG8_SA(1, 0), a3, voffA);
            PG8_WAIT_V(8); PG8_WAIT_L(0); PG8_BAR; PG8_MMA(1, 0, At, B0); PG8_MMA(1, 1, At, B1); PG8_BAR; PG8_SCHED;
            } else {
            PG8_LDB(B0, 0, 0); PG8_SCHED; PG8_LDA(At, 0, 0); PG8_STAGE(PG8_SA(1, 1), a1 + hstep, voffA);
            PG8_WAIT_L(8); PG8_BAR; PG8_WAIT_L(0); PG8_MMA(0, 0, At, B0); PG8_BAR; PG8_SCHED;
            PG8_LDB(B1, 0, 1); PG8_STAGE(PG8_SB(0, 0), b2, voffB);
            PG8_BAR; PG8_WAIT_L(0); PG8_MMA(0, 1, At, B1); PG8_BAR;
            PG8_LDA(At, 0, 1); PG8_STAGE(PG8_SA(0, 0), a2, voffA);
            PG8_BAR; PG8_WAIT_L(0); PG8_MMA(1, 0, At, B0); PG8_BAR; PG8_SCHED;
            PG8_STAGE(PG8_SB(0, 1), b2 + hstep, voffB);
            PG8_WAIT_V(6); PG8_BAR; PG8_MMA(1, 1, At, B1); PG8_BAR;
            PG8_LDB(B0, 1, 0); PG8_SCHED; PG8_LDA(At, 1, 0); PG8_STAGE(PG8_SA(0, 1), a2 + hstep, voffA);
            PG8_WAIT_L(8); PG8_BAR; PG8_WAIT_L(0); PG8_MMA(0, 0, At, B0); PG8_BAR; PG8_SCHED;
            PG8_LDB(B1, 1, 1); PG8_STAGE(PG8_SB(1, 0), b3, voffB);
            PG8_BAR; PG8_WAIT_L(0); PG8_MMA(0, 1, At, B1); PG8_BAR;
            PG8_LDA(At, 1, 1); PG8_STAGE(PG8_SA(1, 0), a3, voffA);
            PG8_BAR; PG8_WAIT_L(0); PG8_MMA(1, 0, At, B0); PG8_BAR; PG8_SCHED;
            PG8_STAGE(PG8_SB(1, 1), b3 + hstep, voffB);
            PG8_WAIT_V(6); PG8_BAR; PG8_MMA(1, 1, At, B1); PG8_BAR;
            }
        }
        if constexpr (ALIGN_EPI) { if (wr == 0) PG8_BAR; }
        if constexpr (!Epi::AFTER_DRAIN) { E(acc, cur, wr, wc, fr, fq); S.done(cur); }
        if (!has_next) break;
#pragma unroll
        for (int a = 0; a < 2; ++a)
#pragma unroll
            for (int b = 0; b < 2; ++b)
#pragma unroll
                for (int m = 0; m < 4; ++m)
#pragma unroll
                    for (int n = 0; n < 2; ++n) acc[a][b][m][n] = (f32x4){0.f, 0.f, 0.f, 0.f};
        cur = nxt; cA = nA; cB = nB; ++ui;
        if constexpr (ALIGN_EPI) { if (wr == 1) PG8_BAR; }
    }
    PG8_WAIT_V(0);
    if constexpr (!ALIGN_EPI) { if (wr == 0) PG8_BAR; }
    PG8_BAR;
    if constexpr (Epi::AFTER_DRAIN) { E.fused(acc, cur, wr, wc, fr, fq, lds, wid, lane); S.done(cur); }
#undef PG8_SA
#undef PG8_SB
#undef PG8_STAGE
#undef PG8_LDA
#undef PG8_LDB
#undef PG8_MMA
#undef PG8_WAIT_V
#undef PG8_WAIT_L
#undef PG8_BAR
#undef PG8_SCHED
}
}
namespace att {
constexpr int D = 128, LDP = 5120, LDO = 2048, GL_OFF = 69632, QL_OFF = 81920; constexpr float THR = 8.f; constexpr bool WSKIP = false;
#ifdef NO_BIAS
#define BIAS_INIT(p0, p1, gt) do { p0 = f32x16{}; p1 = f32x16{}; } while (0)
#else
#define BIAS_INIT(p0, p1, gt) do { _Pragma("unroll") for (int i_ = 0; i_ < 4; ++i_) { const f32x4 g0_ = *(const f32x4*)((gt) + 8 * i_), g1_ = *(const f32x4*)((gt) + 32 + 8 * i_); p0[4 * i_] = g0_[0]; p0[4 * i_ + 1] = g0_[1]; p0[4 * i_ + 2] = g0_[2]; p0[4 * i_ + 3] = g0_[3]; p1[4 * i_] = g1_[0]; p1[4 * i_ + 1] = g1_[1]; p1[4 * i_ + 2] = g1_[2]; p1[4 * i_ + 3] = g1_[3]; } } while (0)
#endif
template <class A, class Bt> struct same_t { static constexpr bool v = false; };
template <class A> struct same_t<A, A> { static constexpr bool v = true; };
constexpr float SCALE = 0.08838834764831845f;
constexpr int NW = 8, QBLK = 32, KVBLK = 64, QB = NW * QBLK;
constexpr int SHM_V = KVBLK * D * 2, SHM_K = KVBLK * D * 2;
constexpr int LDS_BYTES = 2 * SHM_V + 2 * SHM_K + NW * 64 * 4;

using bf16 = __hip_bfloat16;
typedef short bf16x8 __attribute__((ext_vector_type(8)));
typedef short s16x4 __attribute__((ext_vector_type(4)));
typedef float f32x16 __attribute__((ext_vector_type(16)));
typedef float f32x4 __attribute__((ext_vector_type(4)));
typedef unsigned u32x4 __attribute__((ext_vector_type(4)));

#define KSWZ(row, colB) ((row) * 256 + ((colB) ^ (((row) & 7) << 4)))
#define SBAR() __builtin_amdgcn_sched_barrier(0)
__device__ __forceinline__ int v_st(int k, int c) { const int kk = (k & ~0xC) | ((k & 4) << 1) | ((k & 8) >> 1); return ((kk >> 3) * 4 + (c >> 5)) * 512 + ((kk & 7) * 32 + (c & 31)) * 2; }
__device__ __forceinline__ int v_rd_base(int lane) { return ((lane & 3) << 3) | (((lane >> 2) & 3) << 6) | (((lane >> 4) & 1) << 5) | (((lane >> 5) & 1) << 8); }
constexpr int v_rd_off(int d0, int ks, int half) { return d0 * 512 + ks * 4096 + half * 2048; }
__device__ __forceinline__ int crow(int r, int hi) { return (r & 3) + 8 * (r >> 2) + 4 * hi; }
__device__ __forceinline__ unsigned cvtpk(float lo, float hi) {
    unsigned r; asm volatile("v_cvt_pk_bf16_f32 %0, %1, %2" : "=v"(r) : "v"(lo), "v"(hi)); return r;
}
__device__ __forceinline__ bf16x8 pack8(f32x4 a, f32x4 b) {
    u32x4 w = {cvtpk(a[0], a[1]), cvtpk(a[2], a[3]), cvtpk(b[0], b[1]), cvtpk(b[2], b[3])};
    return *reinterpret_cast<bf16x8*>(&w);
}
template <class T> __device__ __forceinline__ bf16x8 load8(const T* p) {
    if constexpr (same_t<T, float>::v) { return pack8(*(const f32x4*)p, *(const f32x4*)(p + 4)); }
    else { return *reinterpret_cast<const bf16x8*>(p); }
}
__device__ __forceinline__ void mask_tile(f32x16& p0, f32x16& p1, int dq, unsigned W) {
    const float NEG = -__builtin_inff();
#pragma unroll
    for (int r = 0; r < 16; ++r) {
        const int c = (r & 3) + 8 * (r >> 2);
        if ((unsigned)(dq - c) >= W) p0[r] = NEG;
        if ((unsigned)(dq - c - 32) >= W) p1[r] = NEG;
    }
}
__device__ __forceinline__ void partialSM(f32x16& p0, f32x16& p1, float& m_reg, float& mn, float& alpha) {
    float pmax = p0[0]; for (int r = 1; r < 16; ++r) pmax = fmaxf(pmax, p0[r]); for (int r = 0; r < 16; ++r) pmax = fmaxf(pmax, p1[r]);
    { auto rr = __builtin_amdgcn_permlane32_swap(__float_as_uint(pmax), __float_as_uint(pmax), false, false);
      pmax = fmaxf(__uint_as_float(rr[0]), __uint_as_float(rr[1])); }
    constexpr float C2 = 1.4426950408889634f * SCALE;
    if (__builtin_expect(__all((pmax - m_reg) * SCALE <= THR), 1)) { mn = m_reg; alpha = 1.f; }
    else { mn = fmaxf(m_reg, pmax); alpha = __builtin_amdgcn_exp2f((m_reg - mn) * C2); m_reg = mn; }
    const float mnL = -mn * C2;
    for (int r = 0; r < 16; ++r) p0[r] = fmaf(p0[r], C2, mnL); for (int r = 0; r < 16; ++r) p1[r] = fmaf(p1[r], C2, mnL);
    for (int r = 0; r < 16; ++r) p0[r] = __builtin_amdgcn_exp2f(p0[r]);
}
__device__ __forceinline__ void finishSM(f32x16& p0, f32x16& p1, float alpha, float& l_reg, bf16x8& pa0, bf16x8& pa1, bf16x8& pa2, bf16x8& pa3) {
    for (int r = 0; r < 16; ++r) p1[r] = __builtin_amdgcn_exp2f(p1[r]);
    float ps = 0; for (int r = 0; r < 16; ++r) ps += p0[r]; for (int r = 0; r < 16; ++r) ps += p1[r];
    { auto rr = __builtin_amdgcn_permlane32_swap(__float_as_uint(ps), __float_as_uint(ps), false, false);
      ps = __uint_as_float(rr[0]) + __uint_as_float(rr[1]); }
    l_reg = l_reg * alpha + ps;
#define PK4(P, B_, OUT) do { unsigned a0 = cvtpk(P[B_+0], P[B_+1]), a1 = cvtpk(P[B_+2], P[B_+3]);                          \
        unsigned b0 = cvtpk(P[B_+4], P[B_+5]), b1 = cvtpk(P[B_+6], P[B_+7]);                                             \
        auto r0 = __builtin_amdgcn_permlane32_swap(a0, b0, false, false); auto r1 = __builtin_amdgcn_permlane32_swap(a1, b1, false, false); \
        u32x4 w = {r0[0], r1[0], r0[1], r1[1]}; OUT = *reinterpret_cast<bf16x8*>(&w); } while (0)
    PK4(p0, 0, pa0); PK4(p0, 8, pa1); PK4(p1, 0, pa2); PK4(p1, 8, pa3);
#undef PK4
}
template <int KB, bool SK>
__device__ __forceinline__ void qkt(f32x16& p0, f32x16& p1, const char* K_lds, int r32, int hi, const bf16x8* qr, bool act, const float* gt) {
    if (SK && !act) { const float NEG = -__builtin_inff();
#pragma unroll
        for (int r = 0; r < 16; ++r) { p0[r] = NEG; p1[r] = NEG; } return; }
    BIAS_INIT(p0, p1, gt);
    const char* kb[4];
#pragma unroll
    for (int dd = 0; dd < 4; ++dd) kb[dd] = K_lds + KB * SHM_K + KSWZ(r32, (dd * 16 + hi * 8) * 2);
#pragma unroll
    for (int d0 = 0; d0 < 8; ++d0) { const char* a = kb[d0 & 3] + (d0 >> 2) * 128;
        bf16x8 b0 = *reinterpret_cast<const bf16x8*>(a);
        bf16x8 b1 = *reinterpret_cast<const bf16x8*>(a + 32 * 256);
        { const bf16x8 qv_ = qr[d0 * 64]; p0 = __builtin_amdgcn_mfma_f32_32x32x16_bf16(b0, qv_, p0, 0, 0, 0);
        p1 = __builtin_amdgcn_mfma_f32_32x32x16_bf16(b1, qv_, p1, 0, 0, 0); } }
}
template <int VB, bool SK>
__device__ __forceinline__ void pv_tile(f32x16* o, int vb0, bf16x8 pa0, bf16x8 pa1, bf16x8 pa2, bf16x8 pa3, bool act) {
    if (SK && !act) return;
#define TRRD(dst, off) asm volatile("ds_read_b64_tr_b16 %0, %1 offset:%2" : "=&v"(dst) : "v"(vb0), "i"(off) : "memory")
#define PV_D0(d0) do { s16x4 l0, l1, l2, l3, h0, h1, h2, h3; constexpr int b_ = VB * SHM_V + v_rd_off(d0, 0, 0);     \
        TRRD(l0, b_); TRRD(h0, b_ + 2048); TRRD(l1, b_ + 4096); TRRD(h1, b_ + 6144); TRRD(l2, b_ + 8192); TRRD(h2, b_ + 10240); TRRD(l3, b_ + 12288); TRRD(h3, b_ + 14336); \
        asm volatile("s_waitcnt lgkmcnt(0)" ::: "memory"); SBAR();                 \
        o[d0] = __builtin_amdgcn_mfma_f32_32x32x16_bf16(pa0, (bf16x8){l0[0], l0[1], l0[2], l0[3], h0[0], h0[1], h0[2], h0[3]}, o[d0], 0, 0, 0);   \
        o[d0] = __builtin_amdgcn_mfma_f32_32x32x16_bf16(pa1, (bf16x8){l1[0], l1[1], l1[2], l1[3], h1[0], h1[1], h1[2], h1[3]}, o[d0], 0, 0, 0);   \
        o[d0] = __builtin_amdgcn_mfma_f32_32x32x16_bf16(pa2, (bf16x8){l2[0], l2[1], l2[2], l2[3], h2[0], h2[1], h2[2], h2[3]}, o[d0], 0, 0, 0);   \
        o[d0] = __builtin_amdgcn_mfma_f32_32x32x16_bf16(pa3, (bf16x8){l3[0], l3[1], l3[2], l3[3], h3[0], h3[1], h3[2], h3[3]}, o[d0], 0, 0, 0); } while (0)
    PV_D0(0); PV_D0(1); PV_D0(2); PV_D0(3);
#undef PV_D0
#undef TRRD
}

template <class TIn, class TOut> struct BlockRef { const TIn* Q; const TIn* K; const TIn* V; TOut* O; int P0; };
template <class TIn> struct Seam {
    bf16x8 qr[8];
    bf16x8 st_v0, st_v1, st_k0, st_k1; f32x4 sf0, sf1, sf2, sf3;
    f32x4 tq[16];
};
__device__ __forceinline__ int swa_jlo(int P0, int W) { const int lowk = P0 - W + 1; return lowk > 0 ? lowk / KVBLK : 0; }
#define ROW(p, k0, rr) ((p) + (size_t)((k0) + (rr)) * LDP + sc)
#define VMW() asm volatile("s_waitcnt vmcnt(0)" ::: "memory")
#define VMWN(n) asm volatile("s_waitcnt vmcnt(%0)" :: "i"(n) : "memory")
#define SLOAD_H(Kp, Vp, k0) do { S.st_v0 = load8<TIn>(ROW(Vp, k0, sr)); S.st_v1 = load8<TIn>(ROW(Vp, k0, 32 + sr));              \
                         S.st_k0 = load8<TIn>(ROW(Kp, k0, sr)); S.st_k1 = load8<TIn>(ROW(Kp, k0, 32 + sr)); } while (0)
#define SWRITE_HK(bf) do { *(bf16x8*)(K_lds + (bf) * SHM_K + kws) = S.st_k0; *(bf16x8*)(K_lds + (bf) * SHM_K + kws + 32 * 256) = S.st_k1; } while (0)
#define SWRITE_HV(bf) do { *(bf16x8*)(V_lds + (bf) * SHM_V + vst0) = S.st_v0; *(bf16x8*)(V_lds + (bf) * SHM_V + vst1) = S.st_v1; } while (0)
#define SWRITE_H(bf) do { SWRITE_HV(bf); SWRITE_HK(bf); } while (0)
#define SLOAD_F(p, k0) do { S.sf0 = *(const f32x4*)ROW(p, k0, sr); S.sf1 = *(const f32x4*)(ROW(p, k0, sr) + 4);                \
                            S.sf2 = *(const f32x4*)ROW(p, k0, 32 + sr); S.sf3 = *(const f32x4*)(ROW(p, k0, 32 + sr) + 4); } while (0)
#define SWRITE_KF(bf) do { *(bf16x8*)(K_lds + (bf) * SHM_K + kws) = pack8(S.sf0, S.sf1); *(bf16x8*)(K_lds + (bf) * SHM_K + kws + 32 * 256) = pack8(S.sf2, S.sf3); } while (0)
#define SWRITE_VF(bf) do { *(bf16x8*)(V_lds + (bf) * SHM_V + vst0) = pack8(S.sf0, S.sf1); *(bf16x8*)(V_lds + (bf) * SHM_V + vst1) = pack8(S.sf2, S.sf3); } while (0)
template <class TIn, class TOut>
__device__ __forceinline__ void causal_swa_prime(const BlockRef<TIn, TOut>& cur, int W, char* lds, Seam<TIn>& S) {
    constexpr bool F32 = same_t<TIn, float>::v;
    const int tid = threadIdx.x, wid = __builtin_amdgcn_readfirstlane(tid >> 6), lane = tid & 63, r32 = lane & 31, hi = lane >> 5;
    const int sr = tid >> 4, sc = (tid & 15) * 8, kws = KSWZ(sr, sc * 2); char* K_lds = lds + 2 * SHM_V;
    const int kb0 = swa_jlo(cur.P0, W) * KVBLK;
    for (int d0 = 0; d0 < 8; ++d0) S.qr[d0] = load8<TIn>(cur.Q + (size_t)(wid * QBLK + r32) * LDP + d0 * 16 + hi * 8);
    if constexpr (F32) { SLOAD_F((const float*)cur.K, kb0); VMW(); SWRITE_KF(0); SBAR(); SLOAD_F((const float*)cur.V, kb0); }
    else { SLOAD_H(cur.K, cur.V, kb0); VMW(); SWRITE_HK(0); }
    __syncthreads();
}
template <class TIn, class TOut>
__device__ __forceinline__ void causal_swa_block(const BlockRef<TIn, TOut>& cur, const BlockRef<TIn, TOut>& nxt, int skv, int W, char* lds, Seam<TIn>& S) {
    constexpr bool F32 = same_t<TIn, float>::v;
    const int tid = threadIdx.x, wid = __builtin_amdgcn_readfirstlane(tid >> 6), lane = tid & 63, r32 = lane & 31, hi = lane >> 5;
    const int j_lo = swa_jlo(cur.P0, W);
    int j_hi = (cur.P0 + QB - 1) / KVBLK + 1; if (j_hi > skv / KVBLK) j_hi = skv / KVBLK;
    const int NT = j_hi - j_lo;
    const int kbn = swa_jlo(nxt.P0, W) * KVBLK;
    const int qlo = cur.P0 + wid * QBLK, qm = qlo + r32 - 4 * hi;
    char* V_lds = lds; char* K_lds = lds + 2 * SHM_V; const float* Gl = (const float*)(lds + GL_OFF);
    float* ws = (float*)(lds + 2 * SHM_V + 2 * SHM_K) + wid * 64; float* li_l = ws, * al_l = ws + 32;
    float m_reg = -1e30f, l_reg = 0; f32x16 o[4] = {};
    const int sr = tid >> 4, sc = (tid & 15) * 8, vst0 = v_st(sr, sc), vst1 = v_st(32 + sr, sc), kws = KSWZ(sr, sc * 2);
    const int vb0 = (int)(uintptr_t)V_lds + v_rd_base(lane);
    const TIn* Kh = cur.K; const TIn* Vh = cur.K + 1024;
    bf16x8* QLp = (bf16x8*)(lds + QL_OFF + wid * 8192) + lane;
    for (int d0 = 0; d0 < 8; ++d0) QLp[d0 * 64] = S.qr[d0];
    SBAR();
#define RESC(a) do { if (__any((a) < 1.f)) { if (hi == 0) al_l[r32] = (a); asm volatile("s_waitcnt lgkmcnt(0)" ::: "memory");              \
                     for (int d_ = 0; d_ < 4; ++d_) for (int r = 0; r < 16; ++r) o[d_][r] *= al_l[crow(r, hi)]; } } while (0)
#define KBASE(t) ((j_lo + (t)) * KVBLK)
#define ACT(t) (KBASE(t) <= qlo + QBLK - 1 && KBASE(t) + KVBLK - 1 >= qlo - W + 1)
#define MASKT(P0_, P1_, t) do { const int kb_ = KBASE(t); if ((!SK || ACT(t)) && (kb_ + KVBLK - 1 > qlo || kb_ <= qlo + QBLK - 1 - W)) mask_tile(P0_, P1_, qm - kb_, (unsigned)W); } while (0)
    constexpr int NQL = F32 ? 16 : 8;
    constexpr bool SK = WSKIP && !F32;
#define SEAM_K0() do { VMWN(NQL); if constexpr (F32) { SWRITE_KF(0); SBAR(); SLOAD_F((const float*)nxt.V, kbn); } else { SWRITE_HK(0); } SBAR(); } while (0)
    f32x16 pA0, pA1, pB0, pB1; float mnA, mnB, alA, alB; bf16x8 pa0, pa1, pa2, pa3;
    if constexpr (F32) { VMW(); SWRITE_VF(0); SBAR(); } else { SWRITE_HV(0); SBAR(); }
    if (NT > 1) { if constexpr (F32) SLOAD_F((const float*)Kh, KBASE(1)); else SLOAD_H(Kh, Vh, KBASE(1)); }
    SBAR(); qkt<0, SK>(pA0, pA1, K_lds, r32, hi, QLp, ACT(0), Gl + KBASE(0) + 4 * hi);
    if constexpr (F32) { if (NT > 1) { VMW(); SWRITE_KF(1); SBAR(); SLOAD_F((const float*)Vh, KBASE(1)); } }
    MASKT(pA0, pA1, 0); partialSM(pA0, pA1, m_reg, mnA, alA);
    if (NT > 1) { VMW(); if constexpr (F32) { SWRITE_VF(1); SBAR(); if (NT > 2) SLOAD_F((const float*)Kh, KBASE(2)); } else SWRITE_H(1); }
    __syncthreads();
#define HALF_STEP(PX0, PX1, mnX, alX, PY0, PY1, alY, t, KB, VB, SB) do {                                                      \
        SBAR(); qkt<KB, SK>(PX0, PX1, K_lds, r32, hi, QLp, ACT(t), Gl + KBASE(t) + 4 * hi);                                             \
        finishSM(PY0, PY1, alY, l_reg, pa0, pa1, pa2, pa3); SBAR();                                                           \
        if ((t) + 1 < NT) { if constexpr (F32) { VMW(); SWRITE_KF(SB); SBAR(); SLOAD_F((const float*)Vh, KBASE((t) + 1)); }  \
                            else { SLOAD_H(Kh, Vh, KBASE((t) + 1)); } SBAR(); }                                               \
        pv_tile<VB, SK>(o, vb0, pa0, pa1, pa2, pa3, ACT((t) - 1)); MASKT(PX0, PX1, (t)); partialSM(PX0, PX1, m_reg, mnX, alX);                                        \
        __syncthreads();                                                                                                      \
        if ((t) + 1 < NT) { VMW(); if constexpr (F32) { SWRITE_VF(SB); SBAR(); if ((t) + 2 < NT) SLOAD_F((const float*)Kh, KBASE((t) + 2)); } \
                            else { SWRITE_H(SB); } }                                                                          \
        RESC(alX); __syncthreads(); } while (0)
    for (int t = 1; t + 1 < NT; t += 2) {
        HALF_STEP(pB0, pB1, mnB, alB, pA0, pA1, alA, t, 1, 0, 0);
        HALF_STEP(pA0, pA1, mnA, alA, pB0, pB1, alB, t + 1, 0, 1, 1);
    }
    const bool even = (NT & 1) == 0;
    if (even) { SBAR(); qkt<1, SK>(pB0, pB1, K_lds, r32, hi, QLp, ACT(NT - 1), Gl + KBASE(NT - 1) + 4 * hi); SBAR(); }
#define QROW(e) (nxt.Q + (size_t)(wid * QBLK + r32) * LDP + ((e) >> 1) * 16 + hi * 8 + ((e) & 1) * 4)
    if constexpr (F32) { SLOAD_F((const float*)nxt.K, kbn); SBAR();
#pragma unroll
        for (int e = 0; e < 8; ++e) S.tq[e] = *(const f32x4*)QROW(e); }
    else { SLOAD_H(nxt.K, nxt.V, kbn); SBAR();
#pragma unroll
        for (int d0 = 0; d0 < 8; ++d0) S.qr[d0] = load8<TIn>(nxt.Q + (size_t)(wid * QBLK + r32) * LDP + d0 * 16 + hi * 8); }
    SBAR();
    finishSM(pA0, pA1, alA, l_reg, pa0, pa1, pa2, pa3); SBAR();
    if constexpr (F32) {
#pragma unroll
        for (int e = 8; e < 16; ++e) S.tq[e] = *(const f32x4*)QROW(e); SBAR(); }
#undef QROW
    pv_tile<0, SK>(o, vb0, pa0, pa1, pa2, pa3, ACT(even ? NT - 2 : NT - 1));
    if (even) { MASKT(pB0, pB1, NT - 1); partialSM(pB0, pB1, m_reg, mnB, alB); __syncthreads(); RESC(alB);
        finishSM(pB0, pB1, alB, l_reg, pa0, pa1, pa2, pa3); SBAR(); pv_tile<1, SK>(o, vb0, pa0, pa1, pa2, pa3, ACT(NT - 1)); }
    SBAR(); SEAM_K0();
    if (hi == 0) li_l[r32] = l_reg; asm volatile("s_waitcnt lgkmcnt(0)" ::: "memory");
    float rli[16];
#pragma unroll
    for (int r = 0; r < 16; ++r) rli[r] = __builtin_amdgcn_rcpf(li_l[crow(r, hi)]);
    TOut* Ow = cur.O + (size_t)(wid * QBLK) * LDO;
#pragma unroll
    for (int r = 0; r < 16; ++r) { const int orow = crow(r, hi);
#pragma unroll
        for (int d0 = 0; d0 < 4; ++d0) { const float v = o[d0][r] * rli[r];
            if constexpr (same_t<TOut, float>::v) { Ow[(size_t)orow * LDO + d0 * 32 + r32] = v; }
            else { const float vn = __shfl_xor(v, 1);
                   if ((r32 & 1) == 0) *(unsigned*)(Ow + (size_t)orow * LDO + d0 * 32 + r32) = cvtpk(v, vn); } } }
    if constexpr (F32) {
#pragma unroll
        for (int d0 = 0; d0 < 8; ++d0) S.qr[d0] = pack8(S.tq[2 * d0], S.tq[2 * d0 + 1]); }
    __syncthreads();
#undef RESC
#undef KBASE
#undef ACT
#undef MASKT
#undef SEAM_K0
#undef HALF_STEP
}
#undef ROW
#undef VMW
#undef VMWN
#undef SLOAD_H
#undef SWRITE_HK
#undef SWRITE_HV
#undef SWRITE_H
#undef SLOAD_F
#undef SWRITE_KF
#undef SWRITE_VF

}
constexpr int NWAVES = 8;
constexpr int BATCH = 8, SEQ = 2048, DM = 2048, M = BATCH * SEQ, NH = 8, HD = 128, NGRP = 8, GC = 128, DFF = 8192, INCOLS = 5128, NP = 5120, NMODC = 12288;
constexpr float EPS = 1e-6f;
#ifndef MK_PER_PHASE
#define MK_PER_PHASE 0
#endif
constexpr int NPHASE = 9;
constexpr size_t MiB = 1u << 20;
constexpr size_t WS_PART = 0;
constexpr size_t WS_MOD = 2 * MiB;
constexpr size_t WS_LS = 3 * MiB;
constexpr size_t WS_WIN = 4 * MiB, WS_WOUT = 24 * MiB, WS_WFF1 = 32 * MiB, WS_WFF2 = 64 * MiB;
constexpr size_t WS_H = 96 * MiB;
constexpr size_t WS_PROJ = 160 * MiB;
constexpr size_t WS_CAT = 320 * MiB;
constexpr size_t WS_A = 160 * MiB;
constexpr size_t WS_END = 416 * MiB;
constexpr int RING_BYTES = 131072, LDS_BYTES = 147456;

#define LAS __attribute__((address_space(3)))
typedef unsigned short bf16;
typedef unsigned v4u __attribute__((ext_vector_type(4)));
typedef unsigned v2u __attribute__((ext_vector_type(2)));
typedef float f32x4 __attribute__((ext_vector_type(4)));
typedef float f32x16 __attribute__((ext_vector_type(16)));
typedef short bf16x8 __attribute__((ext_vector_type(8)));
#define LDS_WAIT() asm volatile("s_waitcnt lgkmcnt(0)" ::: "memory")
__device__ __forceinline__ unsigned f2bf(float f) { unsigned u = __builtin_bit_cast(unsigned, f); return (u + 0x7fffu + ((u >> 16) & 1u)) >> 16; }
__device__ __forceinline__ unsigned pk2(float lo, float hi) { return f2bf(lo) | (f2bf(hi) << 16); }
__device__ __forceinline__ float bflo(unsigned u) { return __builtin_bit_cast(float, u << 16); }
__device__ __forceinline__ float bfhi(unsigned u) { return __builtin_bit_cast(float, u & 0xffff0000u); }
__device__ __forceinline__ float wave_sum(float v) {
#pragma unroll
    for (int o = 1; o < 64; o <<= 1) v += __shfl_xor(v, o);
    return v;
}
struct Args { const float* in[16]; float* out; unsigned char* ws; int ph_lo, ph_hi; };
typedef const __attribute__((address_space(4))) Args* KA;

#define PHASE_IDS() int tid = threadIdx.x; asm volatile("" : "+v"(tid)); const int lane = tid & 63, wave = __builtin_amdgcn_readfirstlane(tid >> 6); \
    int G = gridDim.x, bx = blockIdx.x; asm volatile("" : "+s"(G), "+s"(bx)); const int vcu = (G % 8 == 0) ? (bx % 8) * (G / 8) + bx / 8 : bx; (void)lane; (void)wave; (void)vcu
__device__ __forceinline__ void transpose_item(const float* W, int K, int Nsrc, int nblk, int cshift_from, bf16* WT, LAS float* scr, int item, int lane) {
    const int kb = item / nblk, nb = item % nblk, k0 = 64 * kb, n0 = 32 * nb, c0 = n0 + (n0 >= cshift_from ? 8 : 0);
#pragma unroll 8
    for (int i = 0; i < 32; ++i) { const int kk = 2 * i + (lane >> 5); scr[kk * 33 + (lane & 31)] = W[(size_t)(k0 + kk) * Nsrc + c0 + (lane & 31)]; }
    LDS_WAIT(); asm volatile("" ::: "memory");
    const int c = lane & 7;
#pragma unroll
    for (int j = 0; j < 4; ++j) { const int n = (lane >> 3) + 8 * j; const LAS float* s = scr + (8 * c) * 33 + n;
        v4u o; o.x = pk2(s[0 * 33], s[1 * 33]); o.y = pk2(s[2 * 33], s[3 * 33]); o.z = pk2(s[4 * 33], s[5 * 33]); o.w = pk2(s[6 * 33], s[7 * 33]);
        *(v4u*)(WT + (size_t)(n0 + n) * K + k0 + 8 * c) = o; }
    LDS_WAIT(); asm volatile("" ::: "memory");
}

__device__ __forceinline__ void p0_phase(LAS unsigned char* lds, KA a) {
    PHASE_IDS();
    float* part = (float*)(a->ws + WS_PART);
    for (int u = vcu; u < 192; u += G) {
        const int cgp = u % 48, kq = u / 48, k0 = kq * 512 + wave * 64;
        LAS float* sc = (LAS float*)(lds + 65536 + wave * 2048);
        const float* c = a->in[1];
        for (int i = lane; i < 512; i += 64) { const int kk = i >> 3, b = i & 7; const float cv = c[b * DM + k0 + kk]; sc[i] = cv / (1.f + __expf(-cv)); }
        LDS_WAIT(); asm volatile("" ::: "memory");
        f32x4 acc[8];
#pragma unroll
        for (int b = 0; b < 8; ++b) acc[b] = (f32x4){0.f, 0.f, 0.f, 0.f};
        const float* wp = a->in[2] + (size_t)k0 * NMODC + cgp * 256 + lane * 4;
#pragma unroll 8
        for (int kk = 0; kk < 64; ++kk) { const f32x4 w = *(const f32x4*)(wp + (size_t)kk * NMODC);
            const f32x4 s0 = *(const LAS f32x4*)(sc + kk * 8), s1 = *(const LAS f32x4*)(sc + kk * 8 + 4);
            acc[0] += s0[0] * w; acc[1] += s0[1] * w; acc[2] += s0[2] * w; acc[3] += s0[3] * w;
            acc[4] += s1[0] * w; acc[5] += s1[1] * w; acc[6] += s1[2] * w; acc[7] += s1[3] * w; }
        LAS float* red = (LAS float*)(lds + wave * 8192);
#pragma unroll
        for (int b = 0; b < 8; ++b) *(LAS f32x4*)(red + b * 256 + lane * 4) = acc[b];
        __syncthreads();
#pragma unroll
        for (int i = 0; i < 4; ++i) { const int o = tid + 512 * i; float s = 0.f;
#pragma unroll
            for (int w = 0; w < 8; ++w) s += ((const LAS float*)(lds + w * 8192))[o];
            part[(size_t)kq * (8 * NMODC) + (o >> 8) * NMODC + cgp * 256 + (o & 255)] = s; }
        __syncthreads();
    }
    LAS float* scr = (LAS float*)(lds + wave * 16384);
    const int gw = vcu * NWAVES + wave, NGW = G * NWAVES;
    constexpr int I_IN = (DM / 64) * (NP / 32), I_OUT = (DM / 64) * (DM / 32), I_F1 = (DM / 64) * (DFF / 32), I_F2 = (DFF / 64) * (DM / 32);
    for (int it = gw; it < I_IN + I_OUT + I_F1 + I_F2; it += NGW) {
        int r = it;
        if (r < I_IN) { transpose_item(a->in[5], DM, INCOLS, NP / 32, 3072, (bf16*)(a->ws + WS_WIN), scr, r, lane); continue; } r -= I_IN;
        if (r < I_OUT) { transpose_item(a->in[12], DM, DM, DM / 32, 1 << 30, (bf16*)(a->ws + WS_WOUT), scr, r, lane); continue; } r -= I_OUT;
        if (r < I_F1) { transpose_item(a->in[14], DM, DFF, DFF / 32, 1 << 30, (bf16*)(a->ws + WS_WFF1), scr, r, lane); continue; } r -= I_F1;
        transpose_item(a->in[15], DFF, DM, DM / 32, 1 << 30, (bf16*)(a->ws + WS_WFF2), scr, r, lane);
    }
}

template <bool FL>
__device__ __forceinline__ void norm_row(const float* xrow, bf16* orow, const LAS float* gm, const LAS float* sh, const LAS float* wf, const float* b_f, float* lsrow, int lane) {
    const f32x4* xr = (const f32x4*)xrow + lane;
    f32x4 v[8]; float ss = 0.f;
#pragma unroll
    for (int j = 0; j < 8; ++j) { v[j] = xr[64 * j]; ss += (v[j][0] * v[j][0] + v[j][1] * v[j][1]) + (v[j][2] * v[j][2] + v[j][3] * v[j][3]); }
    const float rstd = 1.0f / sqrtf(wave_sum(ss) * (1.f / DM) + EPS);
    float fl[8];
#pragma unroll
    for (int h = 0; h < 8; ++h) fl[h] = 0.f;
    v2u* o8 = (v2u*)orow + lane;
#pragma unroll
    for (int j = 0; j < 8; ++j) { const f32x4 g = *(const LAS f32x4*)(gm + 4 * lane + 256 * j), s = *(const LAS f32x4*)(sh + 4 * lane + 256 * j);
        const f32x4 hv = v[j] * rstd * g + s;
        v2u w; w.x = pk2(hv[0], hv[1]); w.y = pk2(hv[2], hv[3]); o8[64 * j] = w;
        if (FL) {
#pragma unroll
            for (int h = 0; h < 8; ++h) { const f32x4 wv = *(const LAS f32x4*)(wf + h * DM + 4 * lane + 256 * j); fl[h] += (hv[0] * wv[0] + hv[1] * wv[1]) + (hv[2] * wv[2] + hv[3] * wv[3]); }
            asm volatile("" ::: "memory"); } }
    if (FL) {
#pragma unroll
        for (int h = 0; h < 8; ++h) fl[h] = wave_sum(fl[h]);
        float z = fl[0];
#pragma unroll
        for (int h = 1; h < 8; ++h) z = (lane == h) ? fl[h] : z;
        if (lane < 8) { z += b_f[lane]; lsrow[lane] = fminf(z, 0.f) - log1pf(__expf(-fabsf(z))); }
    }
}

__device__ __forceinline__ void p1_phase(LAS unsigned char* lds, KA a) {
    PHASE_IDS();
    const float* part = (const float*)(a->ws + WS_PART); float* mod = (float*)(a->ws + WS_MOD); const float* b_ada = a->in[3];
    LAS float* wf = (LAS float*)lds; LAS float* gm = (LAS float*)(lds + 65536); LAS float* sh = (LAS float*)(lds + 73728);
    for (int i = tid; i < 8 * DM; i += 512) { const int k = i >> 3, h = i & 7; wf[h * DM + k] = a->in[5][(size_t)k * INCOLS + 3072 + h]; }
    for (int idx = vcu * 512 + tid; idx < 8 * NMODC; idx += G * 512) { float s = b_ada[idx % NMODC];
#pragma unroll
        for (int q = 0; q < 4; ++q) s += part[(size_t)q * (8 * NMODC) + idx];
        mod[idx] = s; }
    for (int ch = vcu; ch < M / 64; ch += G) {
        const int b = ch >> 5;
        __syncthreads();
        for (int j = tid; j < DM; j += 512) { float s0 = b_ada[j], s1 = b_ada[DM + j];
#pragma unroll
            for (int q = 0; q < 4; ++q) { s0 += part[(size_t)q * (8 * NMODC) + b * NMODC + j]; s1 += part[(size_t)q * (8 * NMODC) + b * NMODC + DM + j]; }
            sh[j] = s0; gm[j] = a->in[4][j] * (1.f + s1); }
        __syncthreads();
#pragma unroll 1
        for (int r = 0; r < 8; ++r) { const int m = ch * 64 + wave * 8 + r;
            norm_row<true>(a->in[0] + (size_t)m * DM, (bf16*)(a->ws + WS_H) + (size_t)m * DM, gm, sh, wf, a->in[6], (float*)(a->ws + WS_LS) + (size_t)m * 8, lane); }
    }
}
__device__ __forceinline__ void p6_phase(LAS unsigned char* lds, KA a) {
    PHASE_IDS();
    const float* mod = (const float*)(a->ws + WS_MOD);
    LAS float* gm = (LAS float*)(lds + 65536); LAS float* sh = (LAS float*)(lds + 73728);
    for (int ch = vcu; ch < M / 64; ch += G) {
        const int b = ch >> 5;
        __syncthreads();
        for (int j = tid; j < DM; j += 512) { sh[j] = mod[b * NMODC + 3 * DM + j]; gm[j] = a->in[13][j] * (1.f + mod[b * NMODC + 4 * DM + j]); }
        __syncthreads();
#pragma unroll 1
        for (int r = 0; r < 8; ++r) { const int m = ch * 64 + wave * 8 + r;
            norm_row<false>(a->out + (size_t)m * DM, (bf16*)(a->ws + WS_H) + (size_t)m * DM, gm, sh, nullptr, nullptr, nullptr, lane); }
    }
}
__device__ __forceinline__ void p3_phase(KA a) {
    PHASE_IDS();
    const int gw = vcu * NWAVES + wave, NGW = G * NWAVES; const int sub = (lane & 7) * 16;
    for (int m = gw; m < M; m += NGW)
#pragma unroll
        for (int p = 0; p < 2; ++p) {
            bf16* ptr = (bf16*)(a->ws + WS_PROJ) + (size_t)m * NP + p * 1024 + (lane >> 3) * 128 + sub;
            const float* g = (p ? a->in[8] : a->in[7]) + sub;
            const v4u r0 = *(const v4u*)ptr, r1 = *(const v4u*)(ptr + 8);
            float x[16];
#pragma unroll
            for (int e = 0; e < 4; ++e) { x[2 * e] = bflo(r0[e]); x[2 * e + 1] = bfhi(r0[e]); x[8 + 2 * e] = bflo(r1[e]); x[9 + 2 * e] = bfhi(r1[e]); }
            float ss = 0.f;
#pragma unroll
            for (int e = 0; e < 16; ++e) ss += x[e] * x[e];
            ss += __shfl_xor(ss, 1); ss += __shfl_xor(ss, 2); ss += __shfl_xor(ss, 4);
            const float rstd = 1.0f / sqrtf(ss * (1.f / 128.f) + EPS);
            v4u o0, o1;
#pragma unroll
            for (int e = 0; e < 4; ++e) { o0[e] = pk2(x[2 * e] * rstd * g[2 * e], x[2 * e + 1] * rstd * g[2 * e + 1]); o1[e] = pk2(x[8 + 2 * e] * rstd * g[8 + 2 * e], x[9 + 2 * e] * rstd * g[9 + 2 * e]); }
            *(v4u*)ptr = o0; *(v4u*)(ptr + 8) = o1;
        }
}
constexpr int SG_LDW = 136;
__device__ __forceinline__ void sgu_item(LAS unsigned char* lds, KA a, int item, int tid, int lane, int wave) {
    const int b = item >> 7, n = (item >> 3) & 15, g = item & 7, tok0 = b * SEQ + n * 128;
    const bf16* proj = (const bf16*)(a->ws + WS_PROJ); bf16* cat = (bf16*)(a->ws + WS_CAT);
    LAS bf16* vnT = (LAS bf16*)lds;
    {
        const int tl = tid >> 2, q4 = tid & 3;
        const bf16* vp = proj + (size_t)(tok0 + tl) * NP + 4096 + g * 128 + q4 * 32;
        float x[32];
#pragma unroll
        for (int i = 0; i < 4; ++i) { const v4u r = *(const v4u*)(vp + 8 * i);
#pragma unroll
            for (int e = 0; e < 4; ++e) { x[8 * i + 2 * e] = bflo(r[e]); x[8 * i + 2 * e + 1] = bfhi(r[e]); } }
        float s = 0.f;
#pragma unroll
        for (int e = 0; e < 32; ++e) s += x[e];
        s += __shfl_xor(s, 1); s += __shfl_xor(s, 2);
        const float mean = s * (1.f / 128.f); float q = 0.f;
#pragma unroll
        for (int e = 0; e < 32; ++e) { x[e] -= mean; q += x[e] * x[e]; }
        q += __shfl_xor(q, 1); q += __shfl_xor(q, 2);
        const float rstd = 1.0f / sqrtf(q * (1.f / 128.f) + EPS);
        const float* gl = a->in[9] + g * 128 + q4 * 32;
#pragma unroll
        for (int e = 0; e < 32; ++e) vnT[(q4 * 32 + e) * SG_LDW + tl] = (bf16)f2bf(x[e] * rstd * gl[e]);
    }
    const int tb = wave & 3, chh = wave >> 2, j = lane & 31, hi = lane >> 5, t = tb * 32 + j, nks = 2 * (tb + 1);
    bf16x8 bw[8];
    {   const float* wrow = a->in[10] + ((size_t)g * 128 + t) * 128 + 8 * hi;
#pragma unroll
        for (int ks = 0; ks < 8; ++ks) { v4u w = (v4u){0u, 0u, 0u, 0u};
            if (ks < nks) { const f32x4 w0 = *(const f32x4*)(wrow + ks * 16), w1 = *(const f32x4*)(wrow + ks * 16 + 4); const int s0 = ks * 16 + 8 * hi;
                float f[8] = {w0[0], w0[1], w0[2], w0[3], w1[0], w1[1], w1[2], w1[3]};
#pragma unroll
                for (int e = 0; e < 8; ++e) f[e] = (s0 + e <= t) ? f[e] : 0.f;
                w.x = pk2(f[0], f[1]); w.y = pk2(f[2], f[3]); w.z = pk2(f[4], f[5]); w.w = pk2(f[6], f[7]); }
            bw[ks] = __builtin_bit_cast(bf16x8, w); } }
    __syncthreads();
    f32x16 acc[2];
#pragma unroll
    for (int ct = 0; ct < 2; ++ct) { acc[ct] = (f32x16){};
#pragma unroll
        for (int ks = 0; ks < 8; ++ks) if (ks < nks) {
            const bf16x8 av = *(const LAS bf16x8*)(vnT + (chh * 64 + ct * 32 + j) * SG_LDW + ks * 16 + 8 * hi);
            acc[ct] = __builtin_amdgcn_mfma_f32_32x32x16_bf16(av, bw[ks], acc[ct], 0, 0, 0); } }
    const float bs = a->in[11][g * 128 + t];
    const bf16* up = proj + (size_t)(tok0 + t) * NP + 3072 + g * 128 + chh * 64 + 4 * hi;
    bf16* op = cat + (size_t)(tok0 + t) * DM + 1024 + g * 128 + chh * 64 + 4 * hi;
#pragma unroll
    for (int ct = 0; ct < 2; ++ct)
#pragma unroll
        for (int rg = 0; rg < 4; ++rg) { const v2u uu = *(const v2u*)(up + ct * 32 + 8 * rg);
            const float o0 = bflo(uu.x) * (acc[ct][4 * rg] + bs), o1 = bfhi(uu.x) * (acc[ct][4 * rg + 1] + bs), o2 = bflo(uu.y) * (acc[ct][4 * rg + 2] + bs), o3 = bfhi(uu.y) * (acc[ct][4 * rg + 3] + bs);
            v2u w; w.x = pk2(o0, o1); w.y = pk2(o2, o3); *(v2u*)(op + ct * 32 + 8 * rg) = w; }
    __syncthreads();
}
__device__ __forceinline__ void p4_phase(unsigned char* ldsg, LAS unsigned char* lds, KA a) {
    PHASE_IDS();
    typedef __hip_bfloat16 hb;
    const hb* proj = (const hb*)(a->ws + WS_PROJ); hb* cat = (hb*)(a->ws + WS_CAT); const float* LS = (const float*)(a->ws + WS_LS);
    for (int L = vcu; L < BATCH * NH * 4; L += G) {
        const int bh = L >> 2, x = L & 3, b = bh >> 3, h = bh & 7;
        __syncthreads();
        {
            LAS float* Gl = (LAS float*)(lds + att::GL_OFF); LAS float* wsum = (LAS float*)(lds + att::GL_OFF + 8192);
            const float* lp = LS + ((size_t)b * SEQ + tid * 4) * 8 + h;
            float v0 = lp[0], v1 = lp[8], v2 = lp[16], v3 = lp[24];
            v1 += v0; v2 += v1; v3 += v2;
            float s = v3;
#pragma unroll
            for (int o = 1; o < 64; o <<= 1) { const float tt = __shfl_up(s, o); if (lane >= o) s += tt; }
            if (lane == 63) wsum[wave] = s;
            __syncthreads();
            float base = s - v3;
            for (int w = 0; w < wave; ++w) base += wsum[w];
            const float KS = -11.313708498984761f;
            *(LAS f32x4*)(Gl + tid * 4) = (f32x4){(base + v0) * KS, (base + v1) * KS, (base + v2) * KS, (base + v3) * KS};
        }
        __syncthreads();
        att::BlockRef<hb, hb> blk[2];
#pragma unroll
        for (int p = 0; p < 2; ++p) { const int qb = p ? 7 - x : x;
            blk[p].Q = proj + ((size_t)b * SEQ + qb * 256) * NP + h * 128; blk[p].K = proj + (size_t)b * SEQ * NP + 1024 + h * 128; blk[p].V = proj + (size_t)b * SEQ * NP + 2048 + h * 128;
            blk[p].O = cat + ((size_t)b * SEQ + qb * 256) * DM + h * 128; blk[p].P0 = qb * 256; }
        att::Seam<hb> S;
        att::causal_swa_prime<hb, hb>(blk[0], 1 << 30, (char*)ldsg, S);
        att::causal_swa_block<hb, hb>(blk[0], blk[1], SEQ, 1 << 30, (char*)ldsg, S);
        att::causal_swa_block<hb, hb>(blk[1], blk[1], SEQ, 1 << 30, (char*)ldsg, S);
    }
    __syncthreads();
    for (int it = vcu; it < BATCH * 16 * NGRP; it += G) sgu_item(lds, a, it, tid, lane, wave);
}

__global__ void __launch_bounds__(NWAVES * 64, 2) fwd_kernel(Args a_by_value) {
    KA a = (KA)__builtin_amdgcn_kernarg_segment_ptr();
    extern __shared__ __attribute__((aligned(16))) unsigned char lds_raw[];
    LAS unsigned char* lds = (LAS unsigned char*)lds_raw;
    const int lo = a->ph_lo, hi = a->ph_hi;
#ifdef ONLY_PHASE
#define IN(k) ((k) == ONLY_PHASE && lo <= (k) && (k) < hi)
#else
#define IN(k) (lo <= (k) && (k) < hi)
#endif
#define SEAM(k) do { if (IN(k) && IN((k) + 1)) { cg::this_grid().sync(); } } while (0)
    if (IN(0)) { p0_phase(lds, a); } SEAM(0);
    if (IN(1)) { p1_phase(lds, a); } SEAM(1);
    if (IN(2)) { PHASE_IDS(); unsigned char* ws = a->ws;
        pg8::Gemm g{(const bf16*)(ws + WS_H), (const bf16*)(ws + WS_WIN), M, NP, DM}; pg8::StaticOrder S; S.init(M, NP, G, bx);
        pg8::EpiProj E{(bf16*)(ws + WS_PROJ), NP, 12};
        pg8::gemm_phase<pg8::EpiProj, pg8::StaticOrder, true, true>(lds, g, S, E);
    } SEAM(2);
    if (IN(3)) { p3_phase(a); } SEAM(3);
    if (IN(4)) { p4_phase(lds_raw, lds, a); } SEAM(4);
    if (IN(5)) { PHASE_IDS(); unsigned char* ws = a->ws;
        pg8::Gemm g{(const bf16*)(ws + WS_CAT), (const bf16*)(ws + WS_WOUT), M, DM, DM}; pg8::StaticOrder S; S.init(M, DM, G, bx);
        pg8::EpiRes E{a->in[0], a->out, DM, (const float*)(ws + WS_MOD) + 2 * DM, NMODC};
        pg8::gemm_phase<pg8::EpiRes, pg8::StaticOrder, true, true>(lds, g, S, E);
    } SEAM(5);
    if (IN(6)) { p6_phase(lds, a); } SEAM(6);
    if (IN(7)) { PHASE_IDS(); unsigned char* ws = a->ws;
        pg8::Gemm g{(const bf16*)(ws + WS_H), (const bf16*)(ws + WS_WFF1), M, DFF, DM}; pg8::StaticOrder S; S.init(M, DFF, G, bx);
        pg8::EpiRelu2 E{(bf16*)(ws + WS_A), DFF};
        pg8::gemm_phase<pg8::EpiRelu2, pg8::StaticOrder, true, true>(lds, g, S, E);
    } SEAM(7);
    if (IN(8)) { PHASE_IDS(); unsigned char* ws = a->ws;
        pg8::Gemm g{(const bf16*)(ws + WS_A), (const bf16*)(ws + WS_WFF2), M, DM, DFF}; pg8::StaticOrder S; S.init(M, DM, G, bx);
        pg8::EpiRes E{a->out, a->out, DM, (const float*)(ws + WS_MOD) + 5 * DM, NMODC};
        pg8::gemm_phase<pg8::EpiRes, pg8::StaticOrder, true, true>(lds, g, S, E);
    }
#undef IN
#undef SEAM
}

extern "C" void kernel_launch(void* const* d_in, const int* in_sizes, int n_in, void* d_out, int out_size, void* d_ws, size_t ws_size, hipStream_t stream) {
    static int grid = 0;
    if (grid == 0) {
        if (n_in != 16 || in_sizes[0] != M * DM || out_size != M * DM || ws_size < WS_END) { fprintf(stderr, "kernel_launch: unexpected shapes (n_in %d, in0 %d, out %d, ws %zu)\n", n_in, n_in > 0 ? in_sizes[0] : -1, out_size, ws_size); grid = -1; return; }
        int dev = 0, cus = 0, per_cu = 0;
        if (hipGetDevice(&dev) != hipSuccess || hipDeviceGetAttribute(&cus, hipDeviceAttributeMultiprocessorCount, dev) != hipSuccess) { grid = -1; return; }
        if (hipFuncSetAttribute((const void*)fwd_kernel, hipFuncAttributeMaxDynamicSharedMemorySize, LDS_BYTES) != hipSuccess) { fprintf(stderr, "kernel_launch: hipFuncSetAttribute failed\n"); grid = -1; return; }
        if (hipOccupancyMaxActiveBlocksPerMultiprocessor(&per_cu, (const void*)fwd_kernel, NWAVES * 64, LDS_BYTES) != hipSuccess || per_cu < 1) { fprintf(stderr, "kernel_launch: occupancy query says %d\n", per_cu); (void)hipGetLastError(); per_cu = 1; }
        if (per_cu > 1) per_cu = 1;
        grid = cus * per_cu;
    }
    if (grid < 0) return;
    Args a{};
    for (int i = 0; i < 16; ++i) a.in[i] = (const float*)d_in[i];
    a.out = (float*)d_out; a.ws = (unsigned char*)d_ws;
#if MK_PER_PHASE
    for (int p = 0; p < NPHASE; ++p) { a.ph_lo = p; a.ph_hi = p + 1; hipLaunchKernelGGL(fwd_kernel, dim3(grid), dim3(NWAVES * 64), LDS_BYTES, stream, a); }
#else
    a.ph_lo = 0; a.ph_hi = NPHASE;
    void* args[] = {&a};
    hipError_t e = hipLaunchCooperativeKernel((const void*)fwd_kernel, dim3(grid), dim3(NWAVES * 64), args, LDS_BYTES, stream);
    if (e != hipSuccess) fprintf(stderr, "kernel_launch: cooperative launch failed: %s (grid %d)\n", hipGetErrorString(e), grid);
#endif
}
```

```cpp
#include <hip/hip_runtime.h>
#include <hip/hip_bf16.h>
#include <hip/hip_cooperative_groups.h>
#include <cstdio>
#include <cstdint>
#include <cmath>
namespace cg = cooperative_groups;
namespace pg8 {
#define PG8_LAS __attribute__((address_space(3)))
typedef unsigned short bf16_t;
typedef short bf16x8 __attribute__((ext_vector_type(8)));
typedef float f32x4 __attribute__((ext_vector_type(4)));
typedef unsigned u32x4 __attribute__((ext_vector_type(4)));
constexpr int BM = 256, BK = 64, HALF = 128, HTB = HALF * BK * 2  , STAGE_BYTES = 8 * HTB, NXCD = 8, WGM = 8;

__host__ __device__ __forceinline__ int lds_byte(int r, int c) { const int st = (r >> 4) * 2 + (c >> 5), rr = r & 15, cc = c & 31, ob = rr * 64 + cc * 2; return st * 1024 + (ob ^ (((ob >> 9) & 1) << 5)); }
__host__ __device__ __forceinline__ void stage_rc(int b, int& R, int& C) { const int st = b / 1024, sb = b % 1024, swz = sb ^ (((sb >> 9) & 1) << 5); R = (st >> 1) * 16 + swz / 64; C = (st & 1) * 32 + (swz % 64) / 2; }
__host__ __device__ __forceinline__ int perm32(int rho) { const int n = rho >> 4, i = rho & 15; return 8 * (i >> 2) + 4 * n + (i & 3); }

struct Unit { int pm, pn; };
struct Gemm { const bf16_t* A; const bf16_t* Bt; int M, N, K; };

struct StaticOrder {
    int nM, nN, nwg, G, c, wgm, rev;
    __host__ __device__ void init(int M, int N, int G_, int c_, int wgm_ = WGM, int rev_ = 0) { nM = M / BM; nN = N / BM; nwg = nM * nN; G = G_; c = c_; wgm = wgm_; rev = rev_; }
    __host__ __device__ bool next(int i, Unit& u) const {
        if ((long)i * G + c >= nwg) return false;
        long L = (long)i * G + c; if (rev) { const int R = (nwg - c + G - 1) / G; L = (long)(R - 1 - i) * G + c; }
        int wgid = (int)L; { const int q = nwg / NXCD, r = nwg % NXCD, xcd = wgid % NXCD, off = wgid / NXCD; wgid = (xcd < r ? xcd * (q + 1) : r * (q + 1) + (xcd - r) * q) + off; }
        const int nig = wgm * nN, gid = wgid / nig, fm = gid * wgm, gsz = (nM - fm) < wgm ? (nM - fm) : wgm;
        u.pm = fm + ((wgid % nig) % gsz); u.pn = (wgid % nig) / gsz; return true;
    }
    __device__ __forceinline__ void a_ready(const Unit&) const {}
    __device__ __forceinline__ void done(const Unit&) const {}
};

__device__ __forceinline__ unsigned cvt_pk_bf16(float lo, float hi) { unsigned r; asm volatile("v_cvt_pk_bf16_f32 %0, %1, %2" : "=v"(r) : "v"(lo), "v"(hi)); return r; }
typedef float f32x2 __attribute__((ext_vector_type(2)));
__device__ __forceinline__ float gelu_tanh(float x) { const float u = x * (0.7978845608f + 0.0356774081f * x * x); return x * __builtin_amdgcn_rcpf(1.f + __builtin_amdgcn_exp2f(-2.885390082f * u)); }
struct EpiProj {
    static constexpr bool PERM = true, AFTER_DRAIN = false;
    bf16_t* O; int ldc; int act_from; PG8_LAS float* P; const float* gq; const float* gk; float eps;
    __device__ __forceinline__ void operator()(const f32x4 (&acc)[2][2][4][2], const Unit& u, int wr, int wc, int fr, int fq) const {
        const int row0 = u.pm * BM + wr * 64 + fr, col0 = u.pn * BM + wc * 32 + 8 * fq; const bool act = u.pn >= act_from, nrm = u.pn < 8;
        float rs[2][4][2]; f32x4 g0 = (f32x4){1.f, 1.f, 1.f, 1.f}, g1 = g0;
        if (nrm) {
#pragma unroll
            for (int ai = 0; ai < 2; ++ai)
#pragma unroll
                for (int m = 0; m < 4; ++m)
#pragma unroll
                    for (int bj = 0; bj < 2; ++bj) { const f32x4 a = acc[ai][bj][m][0], b = acc[ai][bj][m][1];
                        float s = (a[0] * a[0] + a[1] * a[1]) + (a[2] * a[2] + a[3] * a[3]) + (b[0] * b[0] + b[1] * b[1]) + (b[2] * b[2] + b[3] * b[3]);
                        s += __shfl_xor(s, 16); s += __shfl_xor(s, 32);
                        if (fq == 0) P[(ai * HALF + wr * 64 + m * 16 + fr) * 8 + bj * 4 + wc] = s; }
            const float* gp = (u.pn < 4 ? gq : gk) + wc * 32 + 8 * fq; g0 = *(const f32x4*)gp; g1 = *(const f32x4*)(gp + 4);
            asm volatile("s_waitcnt lgkmcnt(0)" ::: "memory"); __builtin_amdgcn_s_barrier(); asm volatile("" ::: "memory");
#pragma unroll
            for (int ai = 0; ai < 2; ++ai)
#pragma unroll
                for (int m = 0; m < 4; ++m)
#pragma unroll
                    for (int bj = 0; bj < 2; ++bj) { const f32x4 t = *(const PG8_LAS f32x4*)(P + (ai * HALF + wr * 64 + m * 16 + fr) * 8 + bj * 4);
                        rs[ai][m][bj] = __builtin_amdgcn_rsqf(((t[0] + t[1]) + (t[2] + t[3])) * (1.f / 128.f) + eps);     }
        }
#pragma unroll
        for (int ai = 0; ai < 2; ++ai)
#pragma unroll
            for (int m = 0; m < 4; ++m) { bf16_t* rowp = O + (size_t)(row0 + ai * HALF + m * 16) * ldc + col0;
#pragma unroll
                for (int bj = 0; bj < 2; ++bj) { f32x4 v0 = acc[ai][bj][m][0], v1 = acc[ai][bj][m][1];
                    if (nrm) { v0 = v0 * rs[ai][m][bj] * g0; v1 = v1 * rs[ai][m][bj] * g1; }
                    if (act) {
#pragma unroll
                        for (int e = 0; e < 4; ++e) { v0[e] = gelu_tanh(v0[e]); v1[e] = gelu_tanh(v1[e]); } }
                    u32x4 w; w.x = cvt_pk_bf16(v0[0], v0[1]); w.y = cvt_pk_bf16(v0[2], v0[3]); w.z = cvt_pk_bf16(v1[0], v1[1]); w.w = cvt_pk_bf16(v1[2], v1[3]);
                    *(u32x4*)(rowp + bj * HALF) = w; } }
    }
};
struct EpiFF1 {
    static constexpr bool PERM = true, AFTER_DRAIN = false;
    bf16_t* O; int ldc; const float* rowss; const float* bias; int bstride; float inv_nk, eps;
    __device__ __forceinline__ void operator()(const f32x4 (&acc)[2][2][4][2], const Unit& u, int wr, int wc, int fr, int fq) const {
        const int row0 = u.pm * BM + wr * 64 + fr, col0 = u.pn * BM + wc * 32 + 8 * fq;
        const float* bp = bias + (size_t)(u.pm >> 3) * bstride + col0;
        f32x4 bv[2][2];
#pragma unroll
        for (int bj = 0; bj < 2; ++bj) { bv[bj][0] = *(const f32x4*)(bp + bj * HALF); bv[bj][1] = *(const f32x4*)(bp + bj * HALF + 4); }
#pragma unroll
        for (int ai = 0; ai < 2; ++ai)
#pragma unroll
            for (int m = 0; m < 4; ++m) { const int row = row0 + ai * HALF + m * 16; bf16_t* rowp = O + (size_t)row * ldc + col0;
                const float rstd = __builtin_amdgcn_rsqf(rowss[row] * inv_nk + eps);
#pragma unroll
                for (int bj = 0; bj < 2; ++bj) { f32x4 v0 = acc[ai][bj][m][0] * rstd + bv[bj][0], v1 = acc[ai][bj][m][1] * rstd + bv[bj][1];
#pragma unroll
                    for (int e = 0; e < 4; ++e) { const float a0 = fmaxf(v0[e], 0.f), a1 = fmaxf(v1[e], 0.f); v0[e] = a0 * a0; v1[e] = a1 * a1; }
                    u32x4 w; w.x = cvt_pk_bf16(v0[0], v0[1]); w.y = cvt_pk_bf16(v0[2], v0[3]); w.z = cvt_pk_bf16(v1[0], v1[1]); w.w = cvt_pk_bf16(v1[2], v1[3]);
                    *(u32x4*)(rowp + bj * HALF) = w; } }
    }
};
__device__ __forceinline__ float bf_lo(unsigned u) { return __builtin_bit_cast(float, u << 16); }
__device__ __forceinline__ float bf_hi(unsigned u) { return __builtin_bit_cast(float, u & 0xffff0000u); }
template <bool NEXT> struct EpiRes {
    static constexpr bool PERM = true, AFTER_DRAIN = false;
    const float* base; const bf16_t* baseb; float* out; bf16_t* x1b; int ldc; const float* gate; int gstride; bf16_t* xn; const float* gmul; const float* scl; float* rowss;
    __device__ __forceinline__ void operator()(const f32x4 (&acc)[2][2][4][2], const Unit& u, int wr, int wc, int fr, int fq) const {
        const int row0 = u.pm * BM + wr * 64 + fr, col0 = u.pn * BM + wc * 32 + 8 * fq;
        const float* gp = gate + (size_t)(u.pm >> 3) * gstride + col0;
        f32x4 gv[2][2], mv[2][2];
#pragma unroll
        for (int bj = 0; bj < 2; ++bj)
#pragma unroll
            for (int n = 0; n < 2; ++n) { gv[bj][n] = *(const f32x4*)(gp + bj * HALF + n * 4);
                if (NEXT) mv[bj][n] = *(const f32x4*)(gmul + col0 + bj * HALF + n * 4) * (1.f + *(const f32x4*)(scl + (size_t)(u.pm >> 3) * gstride + col0 + bj * HALF + n * 4)); }
#pragma unroll
        for (int ai = 0; ai < 2; ++ai)
#pragma unroll
            for (int m = 0; m < 4; ++m) { const int row = row0 + ai * HALF + m * 16; const size_t off = (size_t)row * ldc + col0; float ss = 0.f;
#pragma unroll
                for (int bj = 0; bj < 2; ++bj) { f32x4 b0, b1;
                    if (NEXT) { b0 = __builtin_nontemporal_load((const f32x4*)(base + off + bj * HALF)); b1 = __builtin_nontemporal_load((const f32x4*)(base + off + bj * HALF + 4)); }
                    else { const u32x4 r = __builtin_nontemporal_load((const u32x4*)(baseb + off + bj * HALF)); b0 = (f32x4){bf_lo(r.x), bf_hi(r.x), bf_lo(r.y), bf_hi(r.y)}; b1 = (f32x4){bf_lo(r.z), bf_hi(r.z), bf_lo(r.w), bf_hi(r.w)}; }
                    const f32x4 o0 = b0 + gv[bj][0] * acc[ai][bj][m][0], o1 = b1 + gv[bj][1] * acc[ai][bj][m][1];
                    if (!NEXT) { __builtin_nontemporal_store(o0, (f32x4*)(out + off + bj * HALF)); __builtin_nontemporal_store(o1, (f32x4*)(out + off + bj * HALF + 4)); }
                    if (NEXT) { ss += (o0[0] * o0[0] + o0[1] * o0[1]) + (o0[2] * o0[2] + o0[3] * o0[3]) + (o1[0] * o1[0] + o1[1] * o1[1]) + (o1[2] * o1[2] + o1[3] * o1[3]);
                        u32x4 xw; xw.x = cvt_pk_bf16(o0[0], o0[1]); xw.y = cvt_pk_bf16(o0[2], o0[3]); xw.z = cvt_pk_bf16(o1[0], o1[1]); xw.w = cvt_pk_bf16(o1[2], o1[3]);
                        __builtin_nontemporal_store(xw, (u32x4*)(x1b + off + bj * HALF));
                        const f32x4 a0 = o0 * mv[bj][0], a1 = o1 * mv[bj][1];
                        u32x4 w; w.x = cvt_pk_bf16(a0[0], a0[1]); w.y = cvt_pk_bf16(a0[2], a0[3]); w.z = cvt_pk_bf16(a1[0], a1[1]); w.w = cvt_pk_bf16(a1[2], a1[3]);
                        *(u32x4*)(xn + off + bj * HALF) = w; } }
                if (NEXT) { ss += __shfl_xor(ss, 16); ss += __shfl_xor(ss, 32); if (fq == 0) atomicAdd(rowss + row, ss); }
                if (m & 1) asm volatile("" ::: "memory"); }
    }
};
template <class Epi, class Sched, bool ALIGN_EPI = false, bool SP2 = false>
__device__ __forceinline__ void gemm_phase(PG8_LAS unsigned char* lds, const Gemm g, const Sched& S, const Epi& E) {
    const int tid = threadIdx.x, wid = __builtin_amdgcn_readfirstlane(tid >> 6), lane = tid & 63, wr = wid >> 2, wc = wid & 3, fr = lane & 15, fq = lane >> 4;
    const int K = g.K, nt = K / BK;
    unsigned voffA[2], voffB[2];
#pragma unroll
    for (int i = 0; i < 2; ++i) { int R, C; stage_rc(tid * 16 + i * 8192, R, C); const int Rb = Epi::PERM ? ((R & ~31) + perm32(R & 31)) : R;
        voffA[i] = (unsigned)(R * K + C) * 2u; voffB[i] = (unsigned)(Rb * K + C) * 2u; }
    const size_t kstep = (size_t)(BK * 2);
    const size_t hstep = (size_t)HALF * K * 2;
    const size_t tstep = 2 * hstep;
    const unsigned ldsw = (unsigned)wid * 1024u;
    const int aoff = lds_byte(wr * 64 + fr, fq * 8), boff = lds_byte(wc * 32 + fr, fq * 8);
#define PG8_SA(b, h) (((b) * 2 + (h)) * HTB)
#define PG8_SB(b, h) ((4 + (b) * 2 + (h)) * HTB)
#define PG8_STAGE(bufoff, gbase, voff) do { _Pragma("unroll") for (int _i = 0; _i < 2; ++_i) \
        __builtin_amdgcn_global_load_lds((const unsigned*)((const char*)(gbase) + (voff)[_i]), (PG8_LAS unsigned*)(lds + (bufoff) + ldsw + _i * 8192), 16, 0, 0); } while (0)
#define PG8_LDA(dst, b, h) do { _Pragma("unroll") for (int m = 0; m < 4; ++m) _Pragma("unroll") for (int k = 0; k < 2; ++k) dst[m][k] = *(const PG8_LAS bf16x8*)(lds + PG8_SA(b, h) + aoff + m * 2048 + k * 1024); } while (0)
#define PG8_LDB(dst, b, h) do { _Pragma("unroll") for (int n = 0; n < 2; ++n) _Pragma("unroll") for (int k = 0; k < 2; ++k) dst[n][k] = *(const PG8_LAS bf16x8*)(lds + PG8_SB(b, h) + boff + n * 2048 + k * 1024); } while (0)
#define PG8_MMA(ai, bj, At, Bt) do { __builtin_amdgcn_s_setprio(1); _Pragma("unroll") for (int m = 0; m < 4; ++m) _Pragma("unroll") for (int n = 0; n < 2; ++n) _Pragma("unroll") for (int k = 0; k < 2; ++k) \
        acc[ai][bj][m][n] = __builtin_amdgcn_mfma_f32_16x16x32_bf16(Bt[n][k], At[m][k], acc[ai][bj][m][n], 0, 0, 0); __builtin_amdgcn_s_setprio(0); } while (0)
#define PG8_WAIT_V(n) asm volatile("s_waitcnt vmcnt(" #n ")" ::: "memory")
#define PG8_WAIT_L(n) asm volatile("s_waitcnt lgkmcnt(" #n ")" ::: "memory")
#define PG8_BAR __builtin_amdgcn_s_barrier()
#define PG8_SCHED __builtin_amdgcn_sched_barrier(0)
    Unit cur, nxt; int ui = 0;
    if (!S.next(0, cur)) return;
    f32x4 acc[2][2][4][2];
#pragma unroll
    for (int a = 0; a < 2; ++a)
#pragma unroll
        for (int b = 0; b < 2; ++b)
#pragma unroll
            for (int m = 0; m < 4; ++m)
#pragma unroll
                for (int n = 0; n < 2; ++n) acc[a][b][m][n] = (f32x4){0.f, 0.f, 0.f, 0.f};
    bf16x8 At[4][2], B0[2][2], B1[2][2];
    const char* cA = (const char*)g.A + (size_t)cur.pm * tstep; const char* cB = (const char*)g.Bt + (size_t)cur.pn * tstep;
    S.a_ready(cur);
    if constexpr (SP2) {
        PG8_STAGE(PG8_SB(0, 0), cB, voffB); PG8_STAGE(PG8_SB(0, 1), cB + hstep, voffB); PG8_STAGE(PG8_SA(0, 0), cA, voffA); PG8_STAGE(PG8_SA(0, 1), cA + hstep, voffA);
        if (wr == 1) PG8_BAR;
        PG8_WAIT_V(2); PG8_BAR;
        PG8_STAGE(PG8_SB(1, 0), cB + kstep, voffB); PG8_STAGE(PG8_SA(1, 0), cA + kstep, voffA); PG8_STAGE(PG8_SB(1, 1), cB + hstep + kstep, voffB);
        PG8_WAIT_V(6); PG8_BAR;
    } else {
        PG8_STAGE(PG8_SB(0, 0), cB, voffB); PG8_STAGE(PG8_SA(0, 0), cA, voffA); PG8_STAGE(PG8_SB(0, 1), cB + hstep, voffB); PG8_STAGE(PG8_SA(0, 1), cA + hstep, voffA);
        if (wr == 1) PG8_BAR;
        PG8_WAIT_V(4); PG8_BAR;
        PG8_STAGE(PG8_SB(1, 0), cB + kstep, voffB); PG8_STAGE(PG8_SA(1, 0), cA + kstep, voffA); PG8_STAGE(PG8_SB(1, 1), cB + hstep + kstep, voffB);
        PG8_WAIT_V(6); PG8_BAR;
    }
    for (;;) {
        const bool has_next = S.next(ui + 1, nxt);
        const char* nA = has_next ? (const char*)g.A + (size_t)nxt.pm * tstep : cA; const char* nB = has_next ? (const char*)g.Bt + (size_t)nxt.pn * tstep : cB;
        for (int t = 0; t < nt; t += 2) {
            const bool last = (t == nt - 2);
            const char* a1 = cA + (size_t)(t + 1) * kstep;
            const char* a2 = last ? nA : cA + (size_t)(t + 2) * kstep; const char* b2 = last ? nB : cB + (size_t)(t + 2) * kstep;
            const char* a3 = a2 + kstep; const char* b3 = b2 + kstep;
            if (last && has_next) S.a_ready(nxt);
            if constexpr (SP2) {
            PG8_LDB(B0, 0, 0); PG8_LDB(B1, 0, 1); PG8_SCHED; PG8_LDA(At, 0, 0); PG8_STAGE(PG8_SA(1, 1), a1 + hstep, voffA);
            PG8_WAIT_V(8); PG8_WAIT_L(0); PG8_BAR; PG8_MMA(0, 0, At, B0); PG8_MMA(0, 1, At, B1); PG8_BAR; PG8_SCHED;
            PG8_LDA(At, 0, 1); PG8_STAGE(PG8_SB(0, 0), b2, voffB); PG8_STAGE(PG8_SB(0, 1), b2 + hstep, voffB); PG8_STAGE(PG8_SA(0, 0), a2, voffA);
            PG8_WAIT_V(8); PG8_WAIT_L(0); PG8_BAR; PG8_MMA(1, 0, At, B0); PG8_MMA(1, 1, At, B1); PG8_BAR; PG8_SCHED;
            PG8_LDB(B0, 1, 0); PG8_LDB(B1, 1, 1); PG8_SCHED; PG8_LDA(At, 1, 0); PG8_STAGE(PG8_SA(0, 1), a2 + hstep, voffA);
            PG8_WAIT_V(8); PG8_WAIT_L(0); PG8_BAR; PG8_MMA(0, 0, At, B0); PG8_MMA(0, 1, At, B1); PG8_BAR; PG8_SCHED;
            PG8_LDA(At, 1, 1); PG8_STAGE(PG8_SB(1, 0), b3, voffB); PG8_STAGE(PG8_SB(1, 1), b3 + hstep, voffB); PG8_STAGE(PG8_SA(1, 0), a3, voffA);
            PG8_WAIT_V(8); PG8_WAIT_L(0); PG8_BAR; PG8_MMA(1, 0, At, B0); PG8_MMA(1, 1, At, B1); PG8_BAR; PG8_SCHED;
            } else {
            PG8_LDB(B0, 0, 0); PG8_SCHED; PG8_LDA(At, 0, 0); PG8_STAGE(PG8_SA(1, 1), a1 + hstep, voffA);
            PG8_WAIT_L(8); PG8_BAR; PG8_WAIT_L(0); PG8_MMA(0, 0, At, B0); PG8_BAR; PG8_SCHED;
            PG8_LDB(B1, 0, 1); PG8_STAGE(PG8_SB(0, 0), b2, voffB);
            PG8_BAR; PG8_WAIT_L(0); PG8_MMA(0, 1, At, B1); PG8_BAR;
            PG8_LDA(At, 0, 1); PG8_STAGE(PG8_SA(0, 0), a2, voffA);
            PG8_BAR; PG8_WAIT_L(0); PG8_MMA(1, 0, At, B0); PG8_BAR; PG8_SCHED;
            PG8_STAGE(PG8_SB(0, 1), b2 + hstep, voffB);
            PG8_WAIT_V(6); PG8_BAR; PG8_MMA(1, 1, At, B1); PG8_BAR;
            PG8_LDB(B0, 1, 0); PG8_SCHED; PG8_LDA(At, 1, 0); PG8_STAGE(PG8_SA(0, 1), a2 + hstep, voffA);
            PG8_WAIT_L(8); PG8_BAR; PG8_WAIT_L(0); PG8_MMA(0, 0, At, B0); PG8_BAR; PG8_SCHED;
            PG8_LDB(B1, 1, 1); PG8_STAGE(PG8_SB(1, 0), b3, voffB);
            PG8_BAR; PG8_WAIT_L(0); PG8_MMA(0, 1, At, B1); PG8_BAR;
            PG8_LDA(At, 1, 1); PG8_STAGE(PG8_SA(1, 0), a3, voffA);
            PG8_BAR; PG8_WAIT_L(0); PG8_MMA(1, 0, At, B0); PG8_BAR; PG8_SCHED;
            PG8_STAGE(PG8_SB(1, 1), b3 + hstep, voffB);
            PG8_WAIT_V(6); PG8_BAR; PG8_MMA(1, 1, At, B1); PG8_BAR;
            }
        }
        if constexpr (ALIGN_EPI) { if (wr == 0) PG8_BAR; }
        if constexpr (!Epi::AFTER_DRAIN) { E(acc, cur, wr, wc, fr, fq); S.done(cur); }
        if (!has_next) break;
#pragma unroll
        for (int a = 0; a < 2; ++a)
#pragma unroll
            for (int b = 0; b < 2; ++b)
#pragma unroll
                for (int m = 0; m < 4; ++m)
#pragma unroll
                    for (int n = 0; n < 2; ++n) acc[a][b][m][n] = (f32x4){0.f, 0.f, 0.f, 0.f};
        cur = nxt; cA = nA; cB = nB; ++ui;
        if constexpr (ALIGN_EPI) { if (wr == 1) PG8_BAR; }
    }
    PG8_WAIT_V(0);
    if constexpr (!ALIGN_EPI) { if (wr == 0) PG8_BAR; }
    PG8_BAR;
    if constexpr (Epi::AFTER_DRAIN) { E.fused(acc, cur, wr, wc, fr, fq, lds, wid, lane); S.done(cur); }
#undef PG8_SA
#undef PG8_SB
#undef PG8_STAGE
#undef PG8_LDA
#undef PG8_LDB
#undef PG8_MMA
#undef PG8_WAIT_V
#undef PG8_WAIT_L
#undef PG8_BAR
#undef PG8_SCHED
}
}
namespace att {
constexpr int D = 128, LDP = 5120, LDO = 2048, GL_OFF = 69632, QL_OFF = 81920; constexpr float THR = 8.f; constexpr bool WSKIP = false;
#ifdef NO_BIAS
#define BIAS_INIT(p0, p1, gt) do { p0 = f32x16{}; p1 = f32x16{}; } while (0)
#else
#define BIAS_INIT(p0, p1, gt) do { _Pragma("unroll") for (int i_ = 0; i_ < 4; ++i_) { const f32x4 g0_ = *(const f32x4*)((gt) + 8 * i_), g1_ = *(const f32x4*)((gt) + 32 + 8 * i_); p0[4 * i_] = g0_[0]; p0[4 * i_ + 1] = g0_[1]; p0[4 * i_ + 2] = g0_[2]; p0[4 * i_ + 3] = g0_[3]; p1[4 * i_] = g1_[0]; p1[4 * i_ + 1] = g1_[1]; p1[4 * i_ + 2] = g1_[2]; p1[4 * i_ + 3] = g1_[3]; } } while (0)
#endif
template <class A, class Bt> struct same_t { static constexpr bool v = false; };
template <class A> struct same_t<A, A> { static constexpr bool v = true; };
constexpr float SCALE = 0.08838834764831845f;
constexpr int NW = 8, QBLK = 32, KVBLK = 64, QB = NW * QBLK;
constexpr int SHM_V = KVBLK * D * 2, SHM_K = KVBLK * D * 2;
constexpr int LDS_BYTES = 2 * SHM_V + 2 * SHM_K + NW * 64 * 4;

using bf16 = __hip_bfloat16;
typedef short bf16x8 __attribute__((ext_vector_type(8)));
typedef short s16x4 __attribute__((ext_vector_type(4)));
typedef float f32x16 __attribute__((ext_vector_type(16)));
typedef float f32x4 __attribute__((ext_vector_type(4)));
typedef unsigned u32x4 __attribute__((ext_vector_type(4)));

#define KSWZ(row, colB) ((row) * 256 + ((colB) ^ (((row) & 7) << 4)))
#define SBAR() __builtin_amdgcn_sched_barrier(0)
__device__ __forceinline__ int v_st(int k, int c) { const int kk = (k & ~0xC) | ((k & 4) << 1) | ((k & 8) >> 1); return ((kk >> 3) * 4 + (c >> 5)) * 512 + ((kk & 7) * 32 + (c & 31)) * 2; }
__device__ __forceinline__ int v_rd_base(int lane) { return ((lane & 3) << 3) | (((lane >> 2) & 3) << 6) | (((lane >> 4) & 1) << 5) | (((lane >> 5) & 1) << 8); }
constexpr int v_rd_off(int d0, int ks, int half) { return d0 * 512 + ks * 4096 + half * 2048; }
__device__ __forceinline__ int crow(int r, int hi) { return (r & 3) + 8 * (r >> 2) + 4 * hi; }
__device__ __forceinline__ unsigned cvtpk(float lo, float hi) {
    unsigned r; asm volatile("v_cvt_pk_bf16_f32 %0, %1, %2" : "=v"(r) : "v"(lo), "v"(hi)); return r;
}
__device__ __forceinline__ bf16x8 pack8(f32x4 a, f32x4 b) {
    u32x4 w = {cvtpk(a[0], a[1]), cvtpk(a[2], a[3]), cvtpk(b[0], b[1]), cvtpk(b[2], b[3])};
    return *reinterpret_cast<bf16x8*>(&w);
}
template <class T> __device__ __forceinline__ bf16x8 load8(const T* p) {
    if constexpr (same_t<T, float>::v) { return pack8(*(const f32x4*)p, *(const f32x4*)(p + 4)); }
    else { return *reinterpret_cast<const bf16x8*>(p); }
}
__device__ __forceinline__ void mask_tile(f32x16& p0, f32x16& p1, int dq, unsigned W) {
    const float NEG = -__builtin_inff();
#pragma unroll
    for (int r = 0; r < 16; ++r) {
        const int c = (r & 3) + 8 * (r >> 2);
        if ((unsigned)(dq - c) >= W) p0[r] = NEG;
        if ((unsigned)(dq - c - 32) >= W) p1[r] = NEG;
    }
}
__device__ __forceinline__ void partialSM(f32x16& p0, f32x16& p1, float& m_reg, float& mn, float& alpha) {
    float pmax = p0[0]; for (int r = 1; r < 16; ++r) pmax = fmaxf(pmax, p0[r]); for (int r = 0; r < 16; ++r) pmax = fmaxf(pmax, p1[r]);
    { auto rr = __builtin_amdgcn_permlane32_swap(__float_as_uint(pmax), __float_as_uint(pmax), false, false);
      pmax = fmaxf(__uint_as_float(rr[0]), __uint_as_float(rr[1])); }
    constexpr float C2 = 1.4426950408889634f * SCALE;
    if (__builtin_expect(__all((pmax - m_reg) * SCALE <= THR), 1)) { mn = m_reg; alpha = 1.f; }
    else { mn = fmaxf(m_reg, pmax); alpha = __builtin_amdgcn_exp2f((m_reg - mn) * C2); m_reg = mn; }
    const float mnL = -mn * C2;
    for (int r = 0; r < 16; ++r) p0[r] = fmaf(p0[r], C2, mnL); for (int r = 0; r < 16; ++r) p1[r] = fmaf(p1[r], C2, mnL);
    for (int r = 0; r < 16; ++r) p0[r] = __builtin_amdgcn_exp2f(p0[r]);
}
__device__ __forceinline__ void finishSM(f32x16& p0, f32x16& p1, float alpha, float& l_reg, bf16x8& pa0, bf16x8& pa1, bf16x8& pa2, bf16x8& pa3) {
    for (int r = 0; r < 16; ++r) p1[r] = __builtin_amdgcn_exp2f(p1[r]);
    float ps = 0; for (int r = 0; r < 16; ++r) ps += p0[r]; for (int r = 0; r < 16; ++r) ps += p1[r];
    { auto rr = __builtin_amdgcn_permlane32_swap(__float_as_uint(ps), __float_as_uint(ps), false, false);
      ps = __uint_as_float(rr[0]) + __uint_as_float(rr[1]); }
    l_reg = l_reg * alpha + ps;
#define PK4(P, B_, OUT) do { unsigned a0 = cvtpk(P[B_+0], P[B_+1]), a1 = cvtpk(P[B_+2], P[B_+3]);                          \
        unsigned b0 = cvtpk(P[B_+4], P[B_+5]), b1 = cvtpk(P[B_+6], P[B_+7]);                                             \
        auto r0 = __builtin_amdgcn_permlane32_swap(a0, b0, false, false); auto r1 = __builtin_amdgcn_permlane32_swap(a1, b1, false, false); \
        u32x4 w = {r0[0], r1[0], r0[1], r1[1]}; OUT = *reinterpret_cast<bf16x8*>(&w); } while (0)
    PK4(p0, 0, pa0); PK4(p0, 8, pa1); PK4(p1, 0, pa2); PK4(p1, 8, pa3);
#undef PK4
}
template <int KB, bool SK>
__device__ __forceinline__ void qkt(f32x16& p0, f32x16& p1, const char* K_lds, int r32, int hi, const bf16x8* qr, bool act, const float* gt) {
    if (SK && !act) { const float NEG = -__builtin_inff();
#pragma unroll
        for (int r = 0; r < 16; ++r) { p0[r] = NEG; p1[r] = NEG; } return; }
    BIAS_INIT(p0, p1, gt);
    const char* kb[4];
#pragma unroll
    for (int dd = 0; dd < 4; ++dd) kb[dd] = K_lds + KB * SHM_K + KSWZ(r32, (dd * 16 + hi * 8) * 2);
#pragma unroll
    for (int d0 = 0; d0 < 8; ++d0) { const char* a = kb[d0 & 3] + (d0 >> 2) * 128;
        bf16x8 b0 = *reinterpret_cast<const bf16x8*>(a);
        bf16x8 b1 = *reinterpret_cast<const bf16x8*>(a + 32 * 256);
        { const bf16x8 qv_ = qr[d0 * 64]; p0 = __builtin_amdgcn_mfma_f32_32x32x16_bf16(b0, qv_, p0, 0, 0, 0);
        p1 = __builtin_amdgcn_mfma_f32_32x32x16_bf16(b1, qv_, p1, 0, 0, 0); } }
}
template <int VB, bool SK>
__device__ __forceinline__ void pv_tile(f32x16* o, int vb0, bf16x8 pa0, bf16x8 pa1, bf16x8 pa2, bf16x8 pa3, bool act) {
    if (SK && !act) return;
#define TRRD(dst, off) asm volatile("ds_read_b64_tr_b16 %0, %1 offset:%2" : "=&v"(dst) : "v"(vb0), "i"(off) : "memory")
#define PV_D0(d0) do { s16x4 l0, l1, l2, l3, h0, h1, h2, h3; constexpr int b_ = VB * SHM_V + v_rd_off(d0, 0, 0);     \
        TRRD(l0, b_); TRRD(h0, b_ + 2048); TRRD(l1, b_ + 4096); TRRD(h1, b_ + 6144); TRRD(l2, b_ + 8192); TRRD(h2, b_ + 10240); TRRD(l3, b_ + 12288); TRRD(h3, b_ + 14336); \
        asm volatile("s_waitcnt lgkmcnt(0)" ::: "memory"); SBAR();                 \
        o[d0] = __builtin_amdgcn_mfma_f32_32x32x16_bf16(pa0, (bf16x8){l0[0], l0[1], l0[2], l0[3], h0[0], h0[1], h0[2], h0[3]}, o[d0], 0, 0, 0);   \
        o[d0] = __builtin_amdgcn_mfma_f32_32x32x16_bf16(pa1, (bf16x8){l1[0], l1[1], l1[2], l1[3], h1[0], h1[1], h1[2], h1[3]}, o[d0], 0, 0, 0);   \
        o[d0] = __builtin_amdgcn_mfma_f32_32x32x16_bf16(pa2, (bf16x8){l2[0], l2[1], l2[2], l2[3], h2[0], h2[1], h2[2], h2[3]}, o[d0], 0, 0, 0);   \
        o[d0] = __builtin_amdgcn_mfma_f32_32x32x16_bf16(pa3, (bf16x8){l3[0], l3[1], l3[2], l3[3], h3[0], h3[1], h3[2], h3[3]}, o[d0], 0, 0, 0); } while (0)
    PV_D0(0); PV_D0(1); PV_D0(2); PV_D0(3);
#undef PV_D0
#undef TRRD
}

template <class TIn, class TOut> struct BlockRef { const TIn* B; TOut* OB; int P0;
    __device__ __forceinline__ const TIn* Q() const { return B + (size_t)P0 * LDP; } __device__ __forceinline__ const TIn* K() const { return B + 1024; } __device__ __forceinline__ const TIn* V() const { return B + 2048; }
    __device__ __forceinline__ TOut* O() const { return OB + (size_t)P0 * LDO; } };
template <class TIn> struct Seam {
    bf16x8 qr[8];
    bf16x8 st_v0, st_v1, st_k0, st_k1; f32x4 sf0, sf1, sf2, sf3;
    f32x4 tq[16];
};
__device__ __forceinline__ int swa_jlo(int P0, int W) { const int lowk = P0 - W + 1; return lowk > 0 ? lowk / KVBLK : 0; }
#define ROW(p, k0, rr) ((p) + (size_t)((k0) + (rr)) * LDP + sc)
#define VMW() asm volatile("s_waitcnt vmcnt(0)" ::: "memory")
#define VMWN(n) asm volatile("s_waitcnt vmcnt(%0)" :: "i"(n) : "memory")
#define SLOAD_H(Kp, Vp, k0) do { S.st_v0 = load8<TIn>(ROW(Vp, k0, sr)); S.st_v1 = load8<TIn>(ROW(Vp, k0, 32 + sr));              \
                         S.st_k0 = load8<TIn>(ROW(Kp, k0, sr)); S.st_k1 = load8<TIn>(ROW(Kp, k0, 32 + sr)); } while (0)
#define SWRITE_HK(bf) do { *(bf16x8*)(K_lds + (bf) * SHM_K + kws) = S.st_k0; *(bf16x8*)(K_lds + (bf) * SHM_K + kws + 32 * 256) = S.st_k1; } while (0)
#define SWRITE_HV(bf) do { *(bf16x8*)(V_lds + (bf) * SHM_V + vst0) = S.st_v0; *(bf16x8*)(V_lds + (bf) * SHM_V + vst1) = S.st_v1; } while (0)
#define SWRITE_H(bf) do { SWRITE_HV(bf); SWRITE_HK(bf); } while (0)
#define SLOAD_F(p, k0) do { S.sf0 = *(const f32x4*)ROW(p, k0, sr); S.sf1 = *(const f32x4*)(ROW(p, k0, sr) + 4);                \
                            S.sf2 = *(const f32x4*)ROW(p, k0, 32 + sr); S.sf3 = *(const f32x4*)(ROW(p, k0, 32 + sr) + 4); } while (0)
#define SWRITE_KF(bf) do { *(bf16x8*)(K_lds + (bf) * SHM_K + kws) = pack8(S.sf0, S.sf1); *(bf16x8*)(K_lds + (bf) * SHM_K + kws + 32 * 256) = pack8(S.sf2, S.sf3); } while (0)
#define SWRITE_VF(bf) do { *(bf16x8*)(V_lds + (bf) * SHM_V + vst0) = pack8(S.sf0, S.sf1); *(bf16x8*)(V_lds + (bf) * SHM_V + vst1) = pack8(S.sf2, S.sf3); } while (0)
template <class TIn, class TOut>
__device__ __forceinline__ void causal_swa_prime(const BlockRef<TIn, TOut>& cur, int W, char* lds, Seam<TIn>& S) {
    constexpr bool F32 = same_t<TIn, float>::v;
    int tid = threadIdx.x; asm volatile("" : "+v"(tid)); const int wid = __builtin_amdgcn_readfirstlane(tid >> 6), lane = tid & 63, r32 = lane & 31, hi = lane >> 5;
    const int sr = tid >> 4, sc = (tid & 15) * 8, kws = KSWZ(sr, sc * 2); char* K_lds = lds + 2 * SHM_V;
    const int kb0 = swa_jlo(cur.P0, W) * KVBLK;
    if constexpr (F32) { SLOAD_F((const float*)cur.K(), kb0); VMW(); SWRITE_KF(0); SBAR(); SLOAD_F((const float*)cur.V(), kb0); }
    else { SLOAD_H(cur.K(), cur.V(), kb0); VMW(); SWRITE_HK(0); }
    __syncthreads();
}
template <class TIn, class TOut>
__device__ __forceinline__ void causal_swa_block(const BlockRef<TIn, TOut>& cur, const BlockRef<TIn, TOut>& nxt, int skv, int W, char* lds, Seam<TIn>& S) {
    constexpr bool F32 = same_t<TIn, float>::v;
    int tid = threadIdx.x; asm volatile("" : "+v"(tid)); const int wid = __builtin_amdgcn_readfirstlane(tid >> 6), lane = tid & 63, r32 = lane & 31, hi = lane >> 5;
    const int j_lo = swa_jlo(cur.P0, W);
    int j_hi = (cur.P0 + QB - 1) / KVBLK + 1; if (j_hi > skv / KVBLK) j_hi = skv / KVBLK;
    const int NT = j_hi - j_lo;
    const int kbn = swa_jlo(nxt.P0, W) * KVBLK;
    const int qlo = cur.P0 + wid * QBLK, qm = qlo + r32 - 4 * hi;
    char* V_lds = lds; char* K_lds = lds + 2 * SHM_V; const float* Gl = (const float*)(lds + GL_OFF);
    float* ws = (float*)(lds + 2 * SHM_V + 2 * SHM_K) + wid * 64; float* li_l = ws, * al_l = ws + 32;
    float m_reg = -1e30f, l_reg = 0; f32x16 o[4] = {};
    const int sr = tid >> 4, sc = (tid & 15) * 8, vst0 = v_st(sr, sc), vst1 = v_st(32 + sr, sc), kws = KSWZ(sr, sc * 2);
    const int vb0 = (int)(uintptr_t)V_lds + v_rd_base(lane);
    const TIn* Kh = cur.K(); const TIn* Vh = cur.K() + 1024;
    bf16x8* QLp = (bf16x8*)(lds + QL_OFF + wid * 8192) + lane;
    if constexpr (F32) { for (int d0 = 0; d0 < 8; ++d0) QLp[d0 * 64] = S.qr[d0]; }
    else { bf16x8 qt[8];
#pragma unroll
        for (int d0 = 0; d0 < 8; ++d0) qt[d0] = load8<TIn>(cur.Q() + (size_t)(wid * QBLK + r32) * LDP + d0 * 16 + hi * 8);
#pragma unroll
        for (int d0 = 0; d0 < 8; ++d0) QLp[d0 * 64] = qt[d0]; }
    SBAR();
#define RESC(a) do { if (__any((a) < 1.f)) { if (hi == 0) al_l[r32] = (a); asm volatile("s_waitcnt lgkmcnt(0)" ::: "memory");              \
                     for (int d_ = 0; d_ < 4; ++d_) for (int r = 0; r < 16; ++r) o[d_][r] *= al_l[crow(r, hi)]; } } while (0)
#define KBASE(t) ((j_lo + (t)) * KVBLK)
#define ACT(t) (KBASE(t) <= qlo + QBLK - 1 && KBASE(t) + KVBLK - 1 >= qlo - W + 1)
#define MASKT(P0_, P1_, t) do { const int kb_ = KBASE(t); if ((!SK || ACT(t)) && (kb_ + KVBLK - 1 > qlo || kb_ <= qlo + QBLK - 1 - W)) mask_tile(P0_, P1_, qm - kb_, (unsigned)W); } while (0)
    constexpr int NQL = F32 ? 16 : 0;
    constexpr bool SK = WSKIP && !F32;
#define SEAM_K0() do { VMWN(NQL); if constexpr (F32) { SWRITE_KF(0); SBAR(); SLOAD_F((const float*)nxt.V(), kbn); } else { SWRITE_HK(0); } SBAR(); } while (0)
    f32x16 pA0, pA1, pB0, pB1; float mnA, mnB, alA, alB; bf16x8 pa0, pa1, pa2, pa3;
    if constexpr (F32) { VMW(); SWRITE_VF(0); SBAR(); } else { SWRITE_HV(0); SBAR(); }
    if (NT > 1) { if constexpr (F32) SLOAD_F((const float*)Kh, KBASE(1)); else SLOAD_H(Kh, Vh, KBASE(1)); }
    SBAR(); qkt<0, SK>(pA0, pA1, K_lds, r32, hi, QLp, ACT(0), Gl + KBASE(0) + 4 * hi);
    if constexpr (F32) { if (NT > 1) { VMW(); SWRITE_KF(1); SBAR(); SLOAD_F((const float*)Vh, KBASE(1)); } }
    MASKT(pA0, pA1, 0); partialSM(pA0, pA1, m_reg, mnA, alA);
    if (NT > 1) { VMW(); if constexpr (F32) { SWRITE_VF(1); SBAR(); if (NT > 2) SLOAD_F((const float*)Kh, KBASE(2)); } else SWRITE_H(1); }
    __syncthreads();
#define HALF_STEP(PX0, PX1, mnX, alX, PY0, PY1, alY, t, KB, VB, SB) do {                                                      \
        SBAR(); qkt<KB, SK>(PX0, PX1, K_lds, r32, hi, QLp, ACT(t), Gl + KBASE(t) + 4 * hi);                                             \
        finishSM(PY0, PY1, alY, l_reg, pa0, pa1, pa2, pa3); SBAR();                                                           \
        if ((t) + 1 < NT) { if constexpr (F32) { VMW(); SWRITE_KF(SB); SBAR(); SLOAD_F((const float*)Vh, KBASE((t) + 1)); }  \
                            else { SLOAD_H(Kh, Vh, KBASE((t) + 1)); } SBAR(); }                                               \
        pv_tile<VB, SK>(o, vb0, pa0, pa1, pa2, pa3, ACT((t) - 1)); MASKT(PX0, PX1, (t)); partialSM(PX0, PX1, m_reg, mnX, alX);                                        \
        __syncthreads();                                                                                                      \
        if ((t) + 1 < NT) { VMW(); if constexpr (F32) { SWRITE_VF(SB); SBAR(); if ((t) + 2 < NT) SLOAD_F((const float*)Kh, KBASE((t) + 2)); } \
                            else { SWRITE_H(SB); } }                                                                          \
        RESC(alX); __syncthreads(); } while (0)
    for (int t = 1; t + 1 < NT; t += 2) {
        HALF_STEP(pB0, pB1, mnB, alB, pA0, pA1, alA, t, 1, 0, 0);
        HALF_STEP(pA0, pA1, mnA, alA, pB0, pB1, alB, t + 1, 0, 1, 1);
    }
    const bool even = (NT & 1) == 0;
    if (even) { SBAR(); qkt<1, SK>(pB0, pB1, K_lds, r32, hi, QLp, ACT(NT - 1), Gl + KBASE(NT - 1) + 4 * hi); SBAR(); }
#define QROW(e) (nxt.Q() + (size_t)(wid * QBLK + r32) * LDP + ((e) >> 1) * 16 + hi * 8 + ((e) & 1) * 4)
    if constexpr (F32) { SLOAD_F((const float*)nxt.K(), kbn); SBAR();
#pragma unroll
        for (int e = 0; e < 8; ++e) S.tq[e] = *(const f32x4*)QROW(e); }
    else { SLOAD_H(nxt.K(), nxt.V(), kbn); SBAR(); }
    SBAR();
    finishSM(pA0, pA1, alA, l_reg, pa0, pa1, pa2, pa3); SBAR();
    if constexpr (F32) {
#pragma unroll
        for (int e = 8; e < 16; ++e) S.tq[e] = *(const f32x4*)QROW(e); SBAR(); }
#undef QROW
    pv_tile<0, SK>(o, vb0, pa0, pa1, pa2, pa3, ACT(even ? NT - 2 : NT - 1));
    if (even) { MASKT(pB0, pB1, NT - 1); partialSM(pB0, pB1, m_reg, mnB, alB); __syncthreads(); RESC(alB);
        finishSM(pB0, pB1, alB, l_reg, pa0, pa1, pa2, pa3); SBAR(); pv_tile<1, SK>(o, vb0, pa0, pa1, pa2, pa3, ACT(NT - 1)); }
    SBAR(); SEAM_K0();
    if (hi == 0) li_l[r32] = l_reg; asm volatile("s_waitcnt lgkmcnt(0)" ::: "memory");
    float rli[16];
#pragma unroll
    for (int r = 0; r < 16; ++r) rli[r] = __builtin_amdgcn_rcpf(li_l[crow(r, hi)]);
    TOut* Ow = cur.O() + (size_t)(wid * QBLK) * LDO;
#pragma unroll
    for (int r = 0; r < 16; ++r) { const int orow = crow(r, hi);
#pragma unroll
        for (int d0 = 0; d0 < 4; ++d0) { const float v = o[d0][r] * rli[r];
            if constexpr (same_t<TOut, float>::v) { Ow[(size_t)orow * LDO + d0 * 32 + r32] = v; }
            else { const float vn = __shfl_xor(v, 1);
                   if ((r32 & 1) == 0) *(unsigned*)(Ow + (size_t)orow * LDO + d0 * 32 + r32) = cvtpk(v, vn); } } }
    if constexpr (F32) {
#pragma unroll
        for (int d0 = 0; d0 < 8; ++d0) S.qr[d0] = pack8(S.tq[2 * d0], S.tq[2 * d0 + 1]); }
    __syncthreads();
#undef RESC
#undef KBASE
#undef ACT
#undef MASKT
#undef SEAM_K0
#undef HALF_STEP
}
#undef ROW
#undef VMW
#undef VMWN
#undef SLOAD_H
#undef SWRITE_HK
#undef SWRITE_HV
#undef SWRITE_H
#undef SLOAD_F
#undef SWRITE_KF
#undef SWRITE_VF

}
constexpr int NWAVES = 8;
constexpr int BATCH = 8, SEQ = 2048, DM = 2048, M = BATCH * SEQ, NH = 8, HD = 128, NGRP = 8, GC = 128, DFF = 8192, INCOLS = 5128, NP = 5120, NMODC = 12288;
constexpr float EPS = 1e-6f;
#ifndef MK_PER_PHASE
#define MK_PER_PHASE 0
#endif
constexpr int NPHASE = 7;
constexpr size_t MiB = 1u << 20;
constexpr size_t WS_PART = 0;
constexpr size_t WS_MOD = 2 * MiB;
constexpr size_t WS_TS = 2 * MiB + 768 * 1024;
constexpr size_t WS_WF = 2 * MiB + 512 * 1024;
constexpr size_t WS_ROWSS = WS_WF + 65536;
constexpr size_t WS_BIAS2 = 3 * MiB + 512 * 1024;
constexpr size_t WS_BAR = 2 * MiB + 768 * 1024 + 4096, WS_BAR_BYTES = 16384;
constexpr size_t WS_LS = 3 * MiB;
constexpr size_t WS_WIN = 4 * MiB, WS_WOUT = 24 * MiB, WS_WFF1 = 32 * MiB, WS_WFF2 = 64 * MiB;
constexpr size_t WS_H = 96 * MiB;
constexpr size_t WS_PROJ = 160 * MiB;
constexpr size_t WS_CAT = 320 * MiB;
constexpr size_t WS_A = 160 * MiB;
constexpr size_t WS_X1B = 416 * MiB;
constexpr size_t WS_END = 480 * MiB;
constexpr int RING_BYTES = 131072, XB_LDS_OFF = 147456, LDS_BYTES = 147456 + 64;

#define LAS __attribute__((address_space(3)))
typedef unsigned short bf16;
typedef unsigned v4u __attribute__((ext_vector_type(4)));
typedef unsigned v2u __attribute__((ext_vector_type(2)));
typedef float f32x4 __attribute__((ext_vector_type(4)));
typedef float f32x16 __attribute__((ext_vector_type(16)));
typedef short bf16x8 __attribute__((ext_vector_type(8)));
#define LDS_WAIT() asm volatile("s_waitcnt lgkmcnt(0)" ::: "memory")
__device__ __forceinline__ unsigned f2bf(float f) { unsigned u = __builtin_bit_cast(unsigned, f); return (u + 0x7fffu + ((u >> 16) & 1u)) >> 16; }
typedef float f32x2_t __attribute__((ext_vector_type(2))); typedef __bf16 bf16x2_t __attribute__((ext_vector_type(2)));
__device__ __forceinline__ unsigned pk2(float lo, float hi) { const f32x2_t v = {lo, hi}; const bf16x2_t b = __builtin_convertvector(v, bf16x2_t); return __builtin_bit_cast(unsigned, b); }
__device__ __forceinline__ float bflo(unsigned u) { return __builtin_bit_cast(float, u << 16); }
__device__ __forceinline__ float bfhi(unsigned u) { return __builtin_bit_cast(float, u & 0xffff0000u); }
__device__ __forceinline__ float dpp_add(float v, int ctrl) { return v; }
#define DPP_ADD(v, ctrl) ((v) + __builtin_bit_cast(float, __builtin_amdgcn_update_dpp(0, __builtin_bit_cast(int, (v)), (ctrl), 0xF, 0xF, true)))
__device__ __forceinline__ float xrow_sum(float v) {
    { const auto r = __builtin_amdgcn_permlane16_swap(__builtin_bit_cast(unsigned, v), __builtin_bit_cast(unsigned, v), false, false); v = __builtin_bit_cast(float, r[0]) + __builtin_bit_cast(float, r[1]); }
    { const auto r = __builtin_amdgcn_permlane32_swap(__builtin_bit_cast(unsigned, v), __builtin_bit_cast(unsigned, v), false, false); v = __builtin_bit_cast(float, r[0]) + __builtin_bit_cast(float, r[1]); }
    return v;
}
#define DPP_ADD(v, ctrl) ((v) + __builtin_bit_cast(float, __builtin_amdgcn_update_dpp(0, __builtin_bit_cast(int, (v)), (ctrl), 0xF, 0xF, true)))
__device__ __forceinline__ float wave_sum(float v) {
    v = DPP_ADD(v, 0xB1);
    v = DPP_ADD(v, 0x4E);
    v = DPP_ADD(v, 0x141);
    v = DPP_ADD(v, 0x140);
    v += __shfl_xor(v, 16); v += __shfl_xor(v, 32);
    return v;
}
struct Args { const float* in[16]; float* out; unsigned char* ws; int ph_lo, ph_hi; };
typedef const __attribute__((address_space(4))) Args* KA;

#define PHASE_IDS() int tid = threadIdx.x; asm volatile("" : "+v"(tid)); const int lane = tid & 63, wave = __builtin_amdgcn_readfirstlane(tid >> 6); \
    int G = gridDim.x, bx = blockIdx.x; asm volatile("" : "+s"(G), "+s"(bx)); const int vcu = (G % 8 == 0) ? (bx % 8) * (G / 8) + bx / 8 : bx; (void)lane; (void)wave; (void)vcu
struct TItem { const float* src; bf16* dst; int K, Nsrc, nt; };
__device__ __forceinline__ TItem t_decode(KA a, int it) {
    constexpr int I_IN = (DM / 64) * (NP / 64), I_OUT = (DM / 64) * (DM / 64), I_F1 = (DM / 64) * (DFF / 64);
    const float* W; bf16* WT; int K, Nsrc, nblk, shift_from = 1 << 30; int r = it;
    if (r < I_IN) { W = a->in[5]; WT = (bf16*)(a->ws + WS_WIN); K = DM; Nsrc = INCOLS; nblk = NP / 64; shift_from = 3072; }
    else if ((r -= I_IN) < I_OUT) { W = a->in[12]; WT = (bf16*)(a->ws + WS_WOUT); K = DM; Nsrc = DM; nblk = DM / 64; }
    else if ((r -= I_OUT) < I_F1) { W = a->in[14]; WT = (bf16*)(a->ws + WS_WFF1); K = DM; Nsrc = DFF; nblk = DFF / 64; }
    else { r -= I_F1; W = a->in[15]; WT = (bf16*)(a->ws + WS_WFF2); K = DFF; Nsrc = DM; nblk = DM / 64; }
    const int kb = r / nblk, nb = r % nblk, k0 = 64 * kb, n0 = 64 * nb, c0 = n0 + (n0 >= shift_from ? 8 : 0);
    TItem t; t.src = W + (size_t)k0 * Nsrc + c0; t.dst = WT + (size_t)n0 * K + k0; t.K = K; t.Nsrc = Nsrc; t.nt = (W == a->in[15]); return t;
}
__device__ __forceinline__ void t_load(f32x4 (&v)[16], const TItem& t, int lane) {
    const int r = lane >> 4, c4 = (lane & 15) * 4;
#pragma unroll
    for (int i = 0; i < 16; ++i) v[i] = __builtin_nontemporal_load((const f32x4*)(t.src + (size_t)(4 * i + r) * t.Nsrc + c4));
}
__device__ __forceinline__ void t_finish(const f32x4 (&v)[16], const TItem& t, LAS float* scr, int lane) {
    const int r = lane >> 4, c4 = (lane & 15) * 4;
#pragma unroll
    for (int i = 0; i < 16; ++i) { LAS float* s = scr + (4 * i + r) * 65 + c4; s[0] = v[i][0]; s[1] = v[i][1]; s[2] = v[i][2]; s[3] = v[i][3]; }
    LDS_WAIT(); asm volatile("" ::: "memory");
    const int c = lane & 7;
#pragma unroll
    for (int j = 0; j < 8; ++j) { const int n = (lane >> 3) + 8 * j; const LAS float* s = scr + (8 * c) * 65 + n;
        v4u o; o.x = pk2(s[0 * 65], s[1 * 65]); o.y = pk2(s[2 * 65], s[3 * 65]); o.z = pk2(s[4 * 65], s[5 * 65]); o.w = pk2(s[6 * 65], s[7 * 65]);
        if (t.nt) __builtin_nontemporal_store(o, (v4u*)(t.dst + (size_t)n * t.K + 8 * c)); else *(v4u*)(t.dst + (size_t)n * t.K + 8 * c) = o; }
    LDS_WAIT(); asm volatile("" ::: "memory");
}

__device__ __forceinline__ void t_run(KA a, LAS float* scr, int it0, int step, int cnt, int lane) {
    if (cnt > 0) {
        f32x4 va[16], vb[16]; TItem ta = t_decode(a, it0), tb = ta; t_load(va, ta, lane);
#pragma unroll 1
        for (int i = 0; i < cnt; ++i) {
            if (i + 1 < cnt) { tb = t_decode(a, it0 + (i + 1) * step); t_load(vb, tb, lane); }
            t_finish(va, ta, scr, lane);
            ta = tb;
#pragma unroll
            for (int q = 0; q < 16; ++q) va[q] = vb[q];
        }
    }
}

__device__ __forceinline__ void p0_phase(LAS unsigned char* lds, KA a) {
    PHASE_IDS();
    float* part = (float*)(a->ws + WS_PART);
    for (int u = vcu; u < 192; u += G) {
        const int cgp = u % 48, kq = u / 48, k0 = kq * 512 + wave * 64;
        LAS float* sc = (LAS float*)(lds + 65536 + wave * 2048);
        const float* c = a->in[1];
        for (int i = lane; i < 512; i += 64) { const int kk = i >> 3, b = i & 7; const float cv = c[b * DM + k0 + kk]; sc[i] = cv / (1.f + __expf(-cv)); }
        LDS_WAIT(); asm volatile("" ::: "memory");
        f32x4 acc[8];
#pragma unroll
        for (int b = 0; b < 8; ++b) acc[b] = (f32x4){0.f, 0.f, 0.f, 0.f};
        const float* wp = a->in[2] + (size_t)k0 * NMODC + cgp * 256 + lane * 4;
#pragma unroll 16
        for (int kk = 0; kk < 64; ++kk) { const f32x4 w = __builtin_nontemporal_load((const f32x4*)(wp + (size_t)kk * NMODC));
            const f32x4 s0 = *(const LAS f32x4*)(sc + kk * 8), s1 = *(const LAS f32x4*)(sc + kk * 8 + 4);
            acc[0] += s0[0] * w; acc[1] += s0[1] * w; acc[2] += s0[2] * w; acc[3] += s0[3] * w;
            acc[4] += s1[0] * w; acc[5] += s1[1] * w; acc[6] += s1[2] * w; acc[7] += s1[3] * w; }
        LAS float* red = (LAS float*)(lds + wave * 8192);
#pragma unroll
        for (int b = 0; b < 8; ++b) *(LAS f32x4*)(red + b * 256 + lane * 4) = acc[b];
        __syncthreads();
#pragma unroll
        for (int i = 0; i < 4; ++i) { const int o = tid + 512 * i; float s = 0.f;
#pragma unroll
            for (int w = 0; w < 8; ++w) s += ((const LAS float*)(lds + w * 8192))[o];
            part[(size_t)kq * (8 * NMODC) + (o >> 8) * NMODC + cgp * 256 + (o & 255)] = s; }
        __syncthreads();
    }
    LAS float* scr = (LAS float*)(lds + wave * 16640);
    constexpr int NITEMS = (DM / 64) * (NP / 64) + (DM / 64) * (DM / 64);
    static_assert(NITEMS == 192 * 7 + 64 * 35, "item split");
    int it0, cnt, step;
    if (G == 256) { const int b0 = vcu < 192 ? vcu * 7 : 192 * 7 + (vcu - 192) * 35, bc = vcu < 192 ? 7 : 35;
        it0 = b0 + wave; step = NWAVES; cnt = (bc - wave + NWAVES - 1) / NWAVES; }
    else { it0 = vcu * NWAVES + wave; step = G * NWAVES; cnt = it0 < NITEMS ? (NITEMS - it0 + step - 1) / step : 0; }
    t_run(a, scr, it0, step, cnt, lane);
    for (int i = vcu * 512 + tid; i < 8 * DM; i += G * 512) { const int k = i >> 3, h = i & 7; ((float*)(a->ws + WS_WF))[h * DM + k] = a->in[5][(size_t)k * INCOLS + 3072 + h]; }
    for (int i = vcu * 512 + tid; i < M; i += G * 512) ((float*)(a->ws + WS_ROWSS))[i] = 0.f;
}

__device__ __forceinline__ void load_row(f32x4 (&v)[8], const float* xrow, int lane) {
    const f32x4* xr = (const f32x4*)xrow + lane;
#pragma unroll
    for (int j = 0; j < 8; ++j) v[j] = __builtin_nontemporal_load(xr + 64 * j);
}
template <bool FL>
__device__ __forceinline__ void norm_row(const f32x4 (&v)[8], bf16* orow, const LAS float* gm, const LAS float* sh, const LAS float* wf, const float* b_f, float* lsrow, int lane) {
    float ss = 0.f;
#pragma unroll
    for (int j = 0; j < 8; ++j) ss += (v[j][0] * v[j][0] + v[j][1] * v[j][1]) + (v[j][2] * v[j][2] + v[j][3] * v[j][3]);
    const float rstd = 1.0f / sqrtf(wave_sum(ss) * (1.f / DM) + EPS);
    float fl[8];
#pragma unroll
    for (int h = 0; h < 8; ++h) fl[h] = 0.f;
    v2u* o8 = (v2u*)orow + lane;
#pragma unroll
    for (int j = 0; j < 8; ++j) { const f32x4 g = *(const LAS f32x4*)(gm + 4 * lane + 256 * j), s = *(const LAS f32x4*)(sh + 4 * lane + 256 * j);
        const f32x4 hv = v[j] * rstd * g + s;
        v2u w; w.x = pk2(hv[0], hv[1]); w.y = pk2(hv[2], hv[3]); o8[64 * j] = w;
        if (FL) {
#pragma unroll
            for (int h = 0; h < 8; ++h) { const f32x4 wv = *(const LAS f32x4*)(wf + h * DM + 4 * lane + 256 * j); fl[h] += (hv[0] * wv[0] + hv[1] * wv[1]) + (hv[2] * wv[2] + hv[3] * wv[3]); }
            asm volatile("" ::: "memory"); } }
    if (FL) {
#pragma unroll
        for (int h = 0; h < 8; ++h) fl[h] = wave_sum(fl[h]);
        float z = fl[0];
#pragma unroll
        for (int h = 1; h < 8; ++h) z = (lane == h) ? fl[h] : z;
        if (lane < 8) { z += b_f[lane]; lsrow[lane] = fminf(z, 0.f) - log1pf(__expf(-fabsf(z))); }
    }
}

__device__ __forceinline__ void p1_phase(LAS unsigned char* lds, KA a) {
    PHASE_IDS();
    const float* part = (const float*)(a->ws + WS_PART); float* mod = (float*)(a->ws + WS_MOD); const float* b_ada = a->in[3];
    LAS float* wf = (LAS float*)lds; LAS float* gm = (LAS float*)(lds + 65536); LAS float* sh = (LAS float*)(lds + 73728);
    for (int i = tid; i < 8 * DM / 4; i += 512) *(LAS f32x4*)(wf + 4 * i) = *(const f32x4*)((const float*)(a->ws + WS_WF) + 4 * i);
    for (int idx = vcu * 512 + tid; idx < 8 * NMODC; idx += G * 512) { float s = b_ada[idx % NMODC];
#pragma unroll
        for (int q = 0; q < 4; ++q) s += part[(size_t)q * (8 * NMODC) + idx];
        mod[idx] = s; }
    for (int ch = vcu; ch < M / 64; ch += G) {
        const int b = ch >> 5;
        __syncthreads();
        for (int j = tid; j < DM; j += 512) { float s0 = b_ada[j], s1 = b_ada[DM + j];
#pragma unroll
            for (int q = 0; q < 4; ++q) { s0 += part[(size_t)q * (8 * NMODC) + b * NMODC + j]; s1 += part[(size_t)q * (8 * NMODC) + b * NMODC + DM + j]; }
            sh[j] = s0; gm[j] = a->in[4][j] * (1.f + s1); }
        __syncthreads();
        f32x4 v[8], n1[8], n2[8];
        const float* xb = a->in[0] + (size_t)(ch * 64 + wave * 8) * DM;
        load_row(v, xb, lane); load_row(n1, xb + DM, lane);
#pragma unroll 1
        for (int r = 0; r < 8; ++r) { const int m = ch * 64 + wave * 8 + r, r2 = r + 2 < 8 ? r + 2 : 7;
            load_row(n2, xb + (size_t)r2 * DM, lane);
            norm_row<true>(v, (bf16*)(a->ws + WS_H) + (size_t)m * DM, gm, sh, wf, a->in[6], (float*)(a->ws + WS_LS) + (size_t)m * 8, lane);
#pragma unroll
            for (int j = 0; j < 8; ++j) { v[j] = n1[j]; n1[j] = n2[j]; } }
    }
}
constexpr int SG_LDW = 136;
__device__ __forceinline__ void sgu_load_v(v4u (&v)[4], KA a, int item, int tid) {
    const int b = item >> 7, n = (item >> 3) & 15, g = item & 7, tok0 = b * SEQ + n * 128, tl = tid >> 2, q4 = tid & 3;
    const bf16* vp = (const bf16*)(a->ws + WS_PROJ) + (size_t)(tok0 + tl) * NP + 4096 + g * 128 + q4 * 32;
#pragma unroll
    for (int i = 0; i < 4; ++i) v[i] = *(const v4u*)(vp + 8 * i);
}
__device__ __forceinline__ void sgu_item(LAS unsigned char* lds, KA a, int item, int next_item, v4u (&vr)[4], int tid, int lane, int wave) {
    const int b = item >> 7, n = (item >> 3) & 15, g = item & 7, tok0 = b * SEQ + n * 128;
    const bf16* proj = (const bf16*)(a->ws + WS_PROJ); bf16* cat = (bf16*)(a->ws + WS_CAT);
    LAS bf16* vnT = (LAS bf16*)lds;
    const int tb = wave & 3, chh = wave >> 2, j = lane & 31, hi = lane >> 5; int t = tb * 32 + j, nks = 2 * (tb + 1);
    asm volatile("" : "+v"(t), "+s"(nks));
    const bf16* up = proj + (size_t)(tok0 + t) * NP + 3072 + g * 128 + chh * 64 + 4 * hi;
    v2u uu[2][4];
#pragma unroll
    for (int ct = 0; ct < 2; ++ct)
#pragma unroll
        for (int rg = 0; rg < 4; ++rg) uu[ct][rg] = *(const v2u*)(up + ct * 32 + 8 * rg);
    const float bs = a->in[11][g * 128 + t];
    v4u vcur[4];
#pragma unroll
    for (int i = 0; i < 4; ++i) vcur[i] = vr[i];
    sgu_load_v(vr, a, next_item, tid);
    {
        const int tl = tid >> 2, q4 = tid & 3;
        float x[32];
#pragma unroll
        for (int i = 0; i < 4; ++i) {
#pragma unroll
            for (int e = 0; e < 4; ++e) { x[8 * i + 2 * e] = bflo(vcur[i][e]); x[8 * i + 2 * e + 1] = bfhi(vcur[i][e]); } }
        float s = 0.f;
#pragma unroll
        for (int e = 0; e < 32; ++e) s += x[e];
        s += __shfl_xor(s, 1); s += __shfl_xor(s, 2);
        const float mean = s * (1.f / 128.f); float q = 0.f;
#pragma unroll
        for (int e = 0; e < 32; ++e) { x[e] -= mean; q += x[e] * x[e]; }
        q += __shfl_xor(q, 1); q += __shfl_xor(q, 2);
        const float rstd = 1.0f / sqrtf(q * (1.f / 128.f) + EPS);
        const f32x4* gl = (const f32x4*)(a->in[9] + g * 128 + q4 * 32);
#pragma unroll
        for (int e4 = 0; e4 < 8; ++e4) { const f32x4 gv = gl[e4];
#pragma unroll
            for (int e = 0; e < 4; ++e) vnT[(q4 * 32 + 4 * e4 + e) * SG_LDW + tl] = (bf16)pk2(x[4 * e4 + e] * rstd * gv[e], 0.f); }
    }
    bf16x8 bw[8];
    {   const float* wrow = a->in[10] + ((size_t)g * 128 + t) * 128 + 8 * hi;
#pragma unroll
        for (int ks = 0; ks < 8; ++ks) { v4u w = (v4u){0u, 0u, 0u, 0u};
            if (ks < nks) { const f32x4 w0 = *(const f32x4*)(wrow + ks * 16), w1 = *(const f32x4*)(wrow + ks * 16 + 4);
                float f[8] = {w0[0], w0[1], w0[2], w0[3], w1[0], w1[1], w1[2], w1[3]};
                if (ks >= nks - 2) { const int nkeep = t - (ks * 16 + 8 * hi) + 1;
#pragma unroll
                    for (int e = 0; e < 8; ++e) f[e] = (e < nkeep) ? f[e] : 0.f; }
                w.x = pk2(f[0], f[1]); w.y = pk2(f[2], f[3]); w.z = pk2(f[4], f[5]); w.w = pk2(f[6], f[7]); }
            bw[ks] = __builtin_bit_cast(bf16x8, w); } }
    __syncthreads();
    f32x16 acc[2];
#pragma unroll
    for (int ct = 0; ct < 2; ++ct) { acc[ct] = (f32x16){};
#pragma unroll
        for (int ks = 0; ks < 8; ++ks) if (ks < nks) {
            const bf16x8 av = *(const LAS bf16x8*)(vnT + (chh * 64 + ct * 32 + j) * SG_LDW + ks * 16 + 8 * hi);
            acc[ct] = __builtin_amdgcn_mfma_f32_32x32x16_bf16(av, bw[ks], acc[ct], 0, 0, 0); } }
    bf16* op = cat + (size_t)(tok0 + t) * DM + 1024 + g * 128 + chh * 64 + 4 * hi;
#pragma unroll
    for (int ct = 0; ct < 2; ++ct)
#pragma unroll
        for (int rg = 0; rg < 4; ++rg) { const v2u u2 = uu[ct][rg];
            const float o0 = bflo(u2.x) * (acc[ct][4 * rg] + bs), o1 = bfhi(u2.x) * (acc[ct][4 * rg + 1] + bs), o2 = bflo(u2.y) * (acc[ct][4 * rg + 2] + bs), o3 = bfhi(u2.y) * (acc[ct][4 * rg + 3] + bs);
            v2u w; w.x = pk2(o0, o1); w.y = pk2(o2, o3); *(v2u*)(op + ct * 32 + 8 * rg) = w; }
    __syncthreads();
}
__device__ __forceinline__ void bias2_gemv(LAS unsigned char* lds, KA a, int g0, int gstep) {
    {   int tid = threadIdx.x; asm volatile("" : "+v"(tid)); const int lane = tid & 63, wave = __builtin_amdgcn_readfirstlane(tid >> 6);
        LAS float* shl = (LAS float*)lds; LAS float* red = (LAS float*)(lds + 65536);
        const float* mod = (const float*)(a->ws + WS_MOD); const float* W1 = a->in[14]; float* bias2 = (float*)(a->ws + WS_BIAS2);
        for (int i = tid; i < 8 * DM / 4; i += 512) { const int b = i >> 9, j4 = i & 511; *(LAS f32x4*)(shl + b * DM + j4 * 4) = *(const f32x4*)(mod + b * NMODC + 3 * DM + j4 * 4); }
        __syncthreads();
        for (int grp = g0; grp < DFF / 32; grp += gstep) {
            const int n = grp * 32 + (lane & 31), kp = lane >> 5; const float* wp = W1 + (size_t)(wave * 256 + kp) * DFF + n;
            float ab[8];
#pragma unroll
            for (int b = 0; b < 8; ++b) ab[b] = 0.f;
#pragma unroll 1
            for (int k0 = 0; k0 < 256; k0 += 32) { float w[16];
#pragma unroll
                for (int i = 0; i < 16; ++i) w[i] = __builtin_nontemporal_load(wp + (size_t)(k0 + 2 * i) * DFF);
#pragma unroll
                for (int i = 0; i < 16; ++i)
#pragma unroll
                    for (int b = 0; b < 8; ++b) ab[b] += w[i] * shl[b * DM + wave * 256 + k0 + 2 * i + kp]; }
#pragma unroll
            for (int b = 0; b < 8; ++b) { ab[b] += __shfl_xor(ab[b], 32); if (lane < 32) red[(wave * 8 + b) * 32 + lane] = ab[b]; }
            __syncthreads();
            if (tid < 256) { const int b = tid >> 5, nn = tid & 31; float z = 0.f;
#pragma unroll
                for (int w = 0; w < 8; ++w) z += red[(w * 8 + b) * 32 + nn];
                bias2[b * DFF + grp * 32 + nn] = z; }
            __syncthreads(); }
    }
}
#ifdef PROBE_PHASE
#define PSTAMP(k) do { if (blockIdx.x == 0) ((unsigned long long*)(a->ws + WS_TS))[k] = __builtin_amdgcn_s_memrealtime(); } while (0)
#else
#define PSTAMP(k) do { } while (0)
#endif
__device__ __forceinline__ void p4_phase(unsigned char* ldsg, LAS unsigned char* lds, KA a) {
    typedef __hip_bfloat16 hb;
    const hb* proj = (const hb*)(a->ws + WS_PROJ); hb* cat = (hb*)(a->ws + WS_CAT); const float* LS = (const float*)(a->ws + WS_LS);
    PSTAMP(10);
    { int G = gridDim.x, bx = blockIdx.x; asm volatile("" : "+s"(G), "+s"(bx)); const int vcu = (G % 8 == 0) ? (bx % 8) * (G / 8) + bx / 8 : bx;
    for (int L = vcu; L < BATCH * NH * 4; L += G) {
        int tid = threadIdx.x; asm volatile("" : "+v"(tid)); const int lane = tid & 63, wave = __builtin_amdgcn_readfirstlane(tid >> 6);
        const int bh = L >> 2, x = L & 3, b = bh >> 3, h = bh & 7;
        __syncthreads();
        {
            LAS float* Gl = (LAS float*)(lds + att::GL_OFF); LAS float* wsum = (LAS float*)(lds + att::GL_OFF + 8192);
            const float* lp = LS + ((size_t)b * SEQ + tid * 4) * 8 + h;
            float v0 = lp[0], v1 = lp[8], v2 = lp[16], v3 = lp[24];
            v1 += v0; v2 += v1; v3 += v2;
            float s = v3;
#pragma unroll
            for (int o = 1; o < 64; o <<= 1) { const float tt = __shfl_up(s, o); if (lane >= o) s += tt; }
            if (lane == 63) wsum[wave] = s;
            __syncthreads();
            float base = s - v3;
            for (int w = 0; w < wave; ++w) base += wsum[w];
            const float KS = -11.313708498984761f;
            *(LAS f32x4*)(Gl + tid * 4) = (f32x4){(base + v0) * KS, (base + v1) * KS, (base + v2) * KS, (base + v3) * KS};
        }
        __syncthreads();
        att::BlockRef<hb, hb> blk[2];
#pragma unroll
        for (int p = 0; p < 2; ++p) { blk[p].B = proj + (size_t)b * SEQ * NP + h * 128; blk[p].OB = cat + (size_t)b * SEQ * DM + h * 128; blk[p].P0 = (p ? 7 - x : x) * 256; }
        att::Seam<hb> S;
        att::causal_swa_prime<hb, hb>(blk[0], 1 << 30, (char*)ldsg, S);
        att::causal_swa_block<hb, hb>(blk[0], blk[1], SEQ, 1 << 30, (char*)ldsg, S);
        att::causal_swa_block<hb, hb>(blk[1], blk[1], SEQ, 1 << 30, (char*)ldsg, S);
    }
    }
    __syncthreads();
    PSTAMP(11);
    { PHASE_IDS(); constexpr int NSG = BATCH * 16 * NGRP;
      if (vcu < NSG) { v4u vr[4]; sgu_load_v(vr, a, vcu, tid);
          for (int it = vcu; it < NSG; it += G) sgu_item(lds, a, it, it + G < NSG ? it + G : it, vr, tid, lane, wave); } }
    PSTAMP(12);
}

#define XB_TMO      128
#define XB_XCNT(j)  (256  + 64 * (j))
#define XB_XSUB(j)  (1280 + 64 * (j))
#define XB_XGEN(j)  (2304 + 64 * (j))
#define XB_TOP      3328
#define XB_TOPGEN   3392
#define XCD_BAR_WORDS 3456
#define XB_SPIN_CAP (1u << 18)

__device__ __forceinline__ unsigned xb_ld(unsigned* p)              { return __hip_atomic_load(p, __ATOMIC_RELAXED, __HIP_MEMORY_SCOPE_AGENT); }
__device__ __forceinline__ unsigned xb_add(unsigned* p, unsigned v) { return __hip_atomic_fetch_add(p, v, __ATOMIC_RELAXED, __HIP_MEMORY_SCOPE_AGENT); }
__device__ __forceinline__ unsigned xb_xcc_id() { return (unsigned)__builtin_amdgcn_s_getreg((3 << 11) | 20) & 0xFu; }
#define XB_SPIN(cond, bar) do { unsigned _sp = 0; while (cond) { __builtin_amdgcn_s_sleep(1); \
    if ((++_sp & 255u) == 0u) { if (xb_ld(&(bar)[XB_TMO])) break; if (_sp > XB_SPIN_CAP) { atomicAdd(&(bar)[XB_TMO], 1u); break; } } } } while (0)

struct XcdBarrier {
    unsigned* bar; unsigned x;
    volatile LAS unsigned* st;
};

__device__ __forceinline__ XcdBarrier xcd_barrier_post(unsigned* bar, volatile LAS unsigned* st) {
    XcdBarrier b; b.bar = bar; b.x = xb_xcc_id(); b.st = st;
    if (threadIdx.x == 0) (void)xb_add(&bar[XB_XCNT(b.x)], 1u);
    return b;
}
__device__ __forceinline__ void xcd_barrier_complete(unsigned* bar, unsigned x, unsigned& nloc, unsigned& nx) {
    const unsigned G = gridDim.x * gridDim.y * gridDim.z;
    unsigned sum, cnt, mine, sp = 0u;
    for (;;) {
        sum = 0u; cnt = 0u; mine = 0u;
#pragma unroll
        for (unsigned j = 0; j < 16; ++j) { const unsigned c = xb_ld(&bar[XB_XCNT(j)]); sum += c; cnt += (c > 0u) ? 1u : 0u; mine = (j == x) ? c : mine; }
        if (sum == G) break;
        __builtin_amdgcn_s_sleep(1);
        if ((++sp & 255u) == 0u) { if (xb_ld(&bar[XB_TMO])) break; if (sp > XB_SPIN_CAP) { atomicAdd(&bar[XB_TMO], 1u); break; } }
    }
    nloc = mine > 0u ? mine : 1u; nx = cnt > 0u ? cnt : 1u;
}

__device__ __forceinline__ void xcd_barrier(const XcdBarrier& b) {
    asm volatile("s_waitcnt vmcnt(0)" ::: "memory");
    __syncthreads();
    if (threadIdx.x == 0) {
        unsigned* bar = b.bar;
        __builtin_amdgcn_s_waitcnt(0);
        unsigned nloc = b.st[0], nx = b.st[1];
        if (nloc == 0u) { xcd_barrier_complete(bar, b.x, nloc, nx); b.st[0] = nloc; b.st[1] = nx; }
        const unsigned old = xb_add(&bar[XB_XSUB(b.x)], 1u);
        const unsigned gen = old / nloc;
        if (old + 1u == (gen + 1u) * nloc) {
            __builtin_amdgcn_fence(__ATOMIC_RELEASE, "agent");
            asm volatile("s_waitcnt vmcnt(0)" ::: "memory");
            const unsigned og = xb_add(&bar[XB_TOP], 1u);
            const unsigned tg = og / nx;
            if (og + 1u == (tg + 1u) * nx) xb_add(&bar[XB_TOPGEN], 1u);
            else XB_SPIN(xb_ld(&bar[XB_TOPGEN]) == tg, bar);
            __builtin_amdgcn_fence(__ATOMIC_ACQUIRE, "agent");
            xb_add(&bar[XB_XGEN(b.x)], 1u);
            asm volatile("s_waitcnt vmcnt(0)" ::: "memory");
        } else {
            XB_SPIN(xb_ld(&bar[XB_XGEN(b.x)]) == gen, bar);
            __builtin_amdgcn_fence(__ATOMIC_ACQUIRE, "agent");
            asm volatile("s_waitcnt vmcnt(0)" ::: "memory");
        }
    }
    __syncthreads();
}

__global__ void __launch_bounds__(NWAVES * 64, 2) fwd_kernel(Args a_by_value) {
    KA a = (KA)__builtin_amdgcn_kernarg_segment_ptr();
    extern __shared__ __attribute__((aligned(16))) unsigned char lds_raw[];
    LAS unsigned char* lds = (LAS unsigned char*)lds_raw;
    const int lo = a->ph_lo, hi = a->ph_hi;
#ifdef ONLY_PHASE
#define IN(k) ((k) == ONLY_PHASE && lo <= (k) && (k) < hi)
#else
#define IN(k) (lo <= (k) && (k) < hi)
#endif
#ifdef PROBE_PHASE
#define STAMP(k) do { if (blockIdx.x == 0) ((unsigned long long*)(a->ws + WS_TS))[k] = __builtin_amdgcn_s_memrealtime(); } while (0)
#else
#define STAMP(k) do { } while (0)
#endif
    if (threadIdx.x < 2) ((volatile LAS unsigned*)(lds + XB_LDS_OFF))[threadIdx.x] = 0u;
    __syncthreads();
    const XcdBarrier xbar = xcd_barrier_post((unsigned*)(a->ws + WS_BAR), (volatile LAS unsigned*)(lds + XB_LDS_OFF));
    if (lo < 0) cg::this_grid().sync();
#define SEAM(k) do { if (IN(k) && IN((k) + 1)) { xcd_barrier(xbar); } STAMP((k) + 1); } while (0)
    STAMP(0);
    if (IN(0)) { p0_phase(lds, a); } SEAM(0);
    if (IN(1)) { p1_phase(lds, a); } SEAM(1);
    if (IN(2)) { PHASE_IDS(); unsigned char* ws = a->ws;
        pg8::Gemm g{(const bf16*)(ws + WS_H), (const bf16*)(ws + WS_WIN), M, NP, DM}; pg8::StaticOrder S; S.init(M, NP, G, bx, 4);
        pg8::EpiProj E{(bf16*)(ws + WS_PROJ), NP, 12, (LAS float*)(lds + RING_BYTES), a->in[7], a->in[8], EPS};
        if (vcu & 1) { bias2_gemv(lds, a, vcu, G); __syncthreads(); }
        pg8::gemm_phase<pg8::EpiProj, pg8::StaticOrder, true, true>(lds, g, S, E);
        if (!(vcu & 1)) { __syncthreads(); bias2_gemv(lds, a, vcu, G); }
    } SEAM(2);
    if (IN(3)) { p4_phase(lds_raw, lds, a); } SEAM(3);
    if (IN(4)) { PHASE_IDS(); unsigned char* ws = a->ws;
        {
            constexpr int F2_0 = (DM / 64) * (NP / 64) + (DM / 64) * (DM / 64) + (DM / 64) * (DFF / 64), F2_N = (DFF / 64) * (DM / 64);
            const int nodd = G / 2; LAS float* scr = (LAS float*)(lds + wave * 16640);
            if (nodd == 0) { const int i0 = wave; t_run(a, scr, F2_0 + i0, NWAVES, (F2_N - i0 + NWAVES - 1) / NWAVES, lane); }
            else if (vcu & 1) { const int i0 = (vcu >> 1) * NWAVES + wave, st = nodd * NWAVES; if (i0 < F2_N) t_run(a, scr, F2_0 + i0, st, (F2_N - i0 + st - 1) / st, lane); }
            __syncthreads();
        }
        pg8::Gemm g{(const bf16*)(ws + WS_CAT), (const bf16*)(ws + WS_WOUT), M, DM, DM}; pg8::StaticOrder S; S.init(M, DM, G, bx, 4);
        pg8::EpiRes<true> E{a->in[0], nullptr, nullptr, (bf16*)(ws + WS_X1B), DM, (const float*)(ws + WS_MOD) + 2 * DM, NMODC, (bf16*)(ws + WS_H), a->in[13], (const float*)(ws + WS_MOD) + 4 * DM, (float*)(ws + WS_ROWSS)};
        pg8::gemm_phase<pg8::EpiRes<true>, pg8::StaticOrder, true, true>(lds, g, S, E);
        {
            constexpr int F1_0 = (DM / 64) * (NP / 64) + (DM / 64) * (DM / 64), F1_N = (DM / 64) * (DFF / 64);
            const int neven = (G + 1) / 2; LAS float* scr = (LAS float*)(lds + wave * 16640);
            __syncthreads();
            if (!(vcu & 1)) { const int i0 = (vcu >> 1) * NWAVES + wave, st = neven * NWAVES; if (i0 < F1_N) t_run(a, scr, F1_0 + i0, st, (F1_N - i0 + st - 1) / st, lane); }
        }
    } SEAM(4);
    if (IN(5)) { PHASE_IDS(); unsigned char* ws = a->ws;
        pg8::Gemm g{(const bf16*)(ws + WS_H), (const bf16*)(ws + WS_WFF1), M, DFF, DM}; pg8::StaticOrder S; S.init(M, DFF, G, bx, 4);
        pg8::EpiFF1 E{(bf16*)(ws + WS_A), DFF, (const float*)(ws + WS_ROWSS), (const float*)(ws + WS_BIAS2), DFF, 1.f / DM, EPS};
        pg8::gemm_phase<pg8::EpiFF1, pg8::StaticOrder, true, true>(lds, g, S, E);
    } SEAM(5);
    if (IN(6)) { PHASE_IDS(); unsigned char* ws = a->ws;
        pg8::Gemm g{(const bf16*)(ws + WS_A), (const bf16*)(ws + WS_WFF2), M, DM, DFF}; pg8::StaticOrder S; S.init(M, DM, G, bx, 4, 1);
        pg8::EpiRes<false> E{nullptr, (const bf16*)(ws + WS_X1B), a->out, nullptr, DM, (const float*)(ws + WS_MOD) + 5 * DM, NMODC, nullptr, nullptr, nullptr, nullptr};
        pg8::gemm_phase<pg8::EpiRes<false>, pg8::StaticOrder, true, true>(lds, g, S, E);
    }
#ifdef PROBE_PHASE
    xcd_barrier(xbar); STAMP(NPHASE);
    if (blockIdx.x == 0) { const unsigned long long* ts = (const unsigned long long*)(a->ws + WS_TS);
        const float us = (float)(ts[PROBE_END] - ts[PROBE_PHASE]) * 0.01f;
        const float us2 = (float)(ts[PROBE_END2] - ts[PROBE_PHASE2]) * 0.01f;
        if (threadIdx.x == 0) a->out[12345] += us * PROBE_SCALE;
        const float d2 = sqrtf(us2) * 0.0078125f;
        for (int i = threadIdx.x; i < 65536; i += 512) a->out[(1 << 20) + i] += d2; }
#endif
#undef IN
#undef SEAM
}

extern "C" void kernel_launch(void* const* d_in, const int* in_sizes, int n_in, void* d_out, int out_size, void* d_ws, size_t ws_size, hipStream_t stream) {
    static int grid = 0;
    if (grid == 0) {
        if (n_in != 16 || in_sizes[0] != M * DM || out_size != M * DM || ws_size < WS_END) { fprintf(stderr, "kernel_launch: unexpected shapes (n_in %d, in0 %d, out %d, ws %zu)\n", n_in, n_in > 0 ? in_sizes[0] : -1, out_size, ws_size); grid = -1; return; }
        int dev = 0, cus = 0, per_cu = 0;
        if (hipGetDevice(&dev) != hipSuccess || hipDeviceGetAttribute(&cus, hipDeviceAttributeMultiprocessorCount, dev) != hipSuccess) { grid = -1; return; }
        if (hipFuncSetAttribute((const void*)fwd_kernel, hipFuncAttributeMaxDynamicSharedMemorySize, LDS_BYTES) != hipSuccess) { fprintf(stderr, "kernel_launch: hipFuncSetAttribute failed\n"); grid = -1; return; }
        if (hipOccupancyMaxActiveBlocksPerMultiprocessor(&per_cu, (const void*)fwd_kernel, NWAVES * 64, LDS_BYTES) != hipSuccess || per_cu < 1) { fprintf(stderr, "kernel_launch: occupancy query says %d\n", per_cu); (void)hipGetLastError(); per_cu = 1; }
        if (per_cu > 1) per_cu = 1;
        grid = cus * per_cu;
    }
    if (grid < 0) return;
    if (hipMemsetAsync((char*)d_ws + WS_BAR, 0, WS_BAR_BYTES, stream) != hipSuccess) { fprintf(stderr, "kernel_launch: hipMemsetAsync failed\n"); return; }
    Args a{};
    for (int i = 0; i < 16; ++i) a.in[i] = (const float*)d_in[i];
    a.out = (float*)d_out; a.ws = (unsigned char*)d_ws;
#if MK_PER_PHASE
    for (int p = 0; p < NPHASE; ++p) { a.ph_lo = p; a.ph_hi = p + 1; hipLaunchKernelGGL(fwd_kernel, dim3(grid), dim3(NWAVES * 64), LDS_BYTES, stream, a); }
#else
    a.ph_lo = 0; a.ph_hi = NPHASE;
    void* args[] = {&a};
    hipError_t e = hipLaunchCooperativeKernel((const void*)fwd_kernel, dim3(grid), dim3(NWAVES * 64), args, LDS_BYTES, stream);
    if (e != hipSuccess) fprintf(stderr, "kernel_launch: cooperative launch failed: %s (grid %d)\n", hipGetErrorString(e), grid);
#endif
}
```

```cpp
#include <hip/hip_runtime.h>
#include <hip/hip_bf16.h>
#include <hip/hip_cooperative_groups.h>
#include <cstdio>
#include <cstdint>
#include <cmath>
namespace cg = cooperative_groups;
namespace pg8 {
#define PG8_LAS __attribute__((address_space(3)))
typedef unsigned short bf16_t;
typedef short bf16x8 __attribute__((ext_vector_type(8)));
typedef float f32x4 __attribute__((ext_vector_type(4)));
typedef unsigned u32x4 __attribute__((ext_vector_type(4)));
constexpr int BM = 256, BK = 64, HALF = 128, HTB = HALF * BK * 2  , STAGE_BYTES = 8 * HTB, NXCD = 8, WGM = 8;

__host__ __device__ __forceinline__ int lds_byte(int r, int c) { const int st = (r >> 4) * 2 + (c >> 5), rr = r & 15, cc = c & 31, ob = rr * 64 + cc * 2; return st * 1024 + (ob ^ (((ob >> 9) & 1) << 5)); }
__host__ __device__ __forceinline__ void stage_rc(int b, int& R, int& C) { const int st = b / 1024, sb = b % 1024, swz = sb ^ (((sb >> 9) & 1) << 5); R = (st >> 1) * 16 + swz / 64; C = (st & 1) * 32 + (swz % 64) / 2; }
__host__ __device__ __forceinline__ int perm32(int rho) { const int n = rho >> 4, i = rho & 15; return 8 * (i >> 2) + 4 * n + (i & 3); }

struct Unit { int pm, pn; };
struct Gemm { const bf16_t* A; const bf16_t* Bt; int M, N, K; };

struct StaticOrder {
    int nM, nN, nwg, G, c, wgm, rev;
    __host__ __device__ void init(int M, int N, int G_, int c_, int wgm_ = WGM, int rev_ = 0) { nM = M / BM; nN = N / BM; nwg = nM * nN; G = G_; c = c_; wgm = wgm_; rev = rev_; }
    __host__ __device__ bool next(int i, Unit& u) const {
        if ((long)i * G + c >= nwg) return false;
        long L = (long)i * G + c; if (rev) { const int R = (nwg - c + G - 1) / G; L = (long)(R - 1 - i) * G + c; }
        int wgid = (int)L; { const int q = nwg / NXCD, r = nwg % NXCD, xcd = wgid % NXCD, off = wgid / NXCD; wgid = (xcd < r ? xcd * (q + 1) : r * (q + 1) + (xcd - r) * q) + off; }
        const int nig = wgm * nN, gid = wgid / nig, fm = gid * wgm, gsz = (nM - fm) < wgm ? (nM - fm) : wgm;
        u.pm = fm + ((wgid % nig) % gsz); u.pn = (wgid % nig) / gsz; return true;
    }
    __device__ __forceinline__ void a_ready(const Unit&) const {}
    __device__ __forceinline__ void done(const Unit&) const {}
};

__device__ __forceinline__ unsigned cvt_pk_bf16(float lo, float hi) { unsigned r; asm volatile("v_cvt_pk_bf16_f32 %0, %1, %2" : "=v"(r) : "v"(lo), "v"(hi)); return r; }
typedef float f32x2 __attribute__((ext_vector_type(2)));
__device__ __forceinline__ float gelu_tanh(float x) { const float u = x * (0.7978845608f + 0.0356774081f * x * x); return x * __builtin_amdgcn_rcpf(1.f + __builtin_amdgcn_exp2f(-2.885390082f * u)); }
struct EpiProj {
    static constexpr bool PERM = true, AFTER_DRAIN = false;
    bf16_t* O; int ldc; int act_from; PG8_LAS float* P; const float* gq; const float* gk; float eps;
    __device__ __forceinline__ void operator()(const f32x4 (&acc)[2][2][4][2], const Unit& u, int wr, int wc, int fr, int fq) const {
        const int row0 = u.pm * BM + wr * 64 + fr, col0 = u.pn * BM + wc * 32 + 8 * fq; const bool act = u.pn >= act_from, nrm = u.pn < 8;
        float rs[2][4][2]; f32x4 g0 = (f32x4){1.f, 1.f, 1.f, 1.f}, g1 = g0;
        if (nrm) {
#pragma unroll
            for (int ai = 0; ai < 2; ++ai)
#pragma unroll
                for (int m = 0; m < 4; ++m)
#pragma unroll
                    for (int bj = 0; bj < 2; ++bj) { const f32x4 a = acc[ai][bj][m][0], b = acc[ai][bj][m][1];
                        float s = (a[0] * a[0] + a[1] * a[1]) + (a[2] * a[2] + a[3] * a[3]) + (b[0] * b[0] + b[1] * b[1]) + (b[2] * b[2] + b[3] * b[3]);
                        s += __shfl_xor(s, 16); s += __shfl_xor(s, 32);
                        if (fq == 0) P[(ai * HALF + wr * 64 + m * 16 + fr) * 8 + bj * 4 + wc] = s; }
            const float* gp = (u.pn < 4 ? gq : gk) + wc * 32 + 8 * fq; g0 = *(const f32x4*)gp; g1 = *(const f32x4*)(gp + 4);
            asm volatile("s_waitcnt lgkmcnt(0)" ::: "memory"); __builtin_amdgcn_s_barrier(); asm volatile("" ::: "memory");
#pragma unroll
            for (int ai = 0; ai < 2; ++ai)
#pragma unroll
                for (int m = 0; m < 4; ++m)
#pragma unroll
                    for (int bj = 0; bj < 2; ++bj) { const f32x4 t = *(const PG8_LAS f32x4*)(P + (ai * HALF + wr * 64 + m * 16 + fr) * 8 + bj * 4);
                        rs[ai][m][bj] = __builtin_amdgcn_rsqf(((t[0] + t[1]) + (t[2] + t[3])) * (1.f / 128.f) + eps);     }
        }
#pragma unroll
        for (int ai = 0; ai < 2; ++ai)
#pragma unroll
            for (int m = 0; m < 4; ++m) { bf16_t* rowp = O + (size_t)(row0 + ai * HALF + m * 16) * ldc + col0;
#pragma unroll
                for (int bj = 0; bj < 2; ++bj) { f32x4 v0 = acc[ai][bj][m][0], v1 = acc[ai][bj][m][1];
                    if (nrm) { v0 = v0 * rs[ai][m][bj] * g0; v1 = v1 * rs[ai][m][bj] * g1; }
                    if (act) {
#pragma unroll
                        for (int e = 0; e < 4; ++e) { v0[e] = gelu_tanh(v0[e]); v1[e] = gelu_tanh(v1[e]); } }
                    u32x4 w; w.x = cvt_pk_bf16(v0[0], v0[1]); w.y = cvt_pk_bf16(v0[2], v0[3]); w.z = cvt_pk_bf16(v1[0], v1[1]); w.w = cvt_pk_bf16(v1[2], v1[3]);
                    *(u32x4*)(rowp + bj * HALF) = w; } }
    }
};
struct EpiFF1 {
    static constexpr bool PERM = true, AFTER_DRAIN = false;
    bf16_t* O; int ldc; const float* rowss; const float* bias; int bstride; float inv_nk, eps;
    __device__ __forceinline__ void operator()(const f32x4 (&acc)[2][2][4][2], const Unit& u, int wr, int wc, int fr, int fq) const {
        const int row0 = u.pm * BM + wr * 64 + fr, col0 = u.pn * BM + wc * 32 + 8 * fq;
        const float* bp = bias + (size_t)(u.pm >> 3) * bstride + col0;
        f32x4 bv[2][2];
#pragma unroll
        for (int bj = 0; bj < 2; ++bj) { bv[bj][0] = *(const f32x4*)(bp + bj * HALF); bv[bj][1] = *(const f32x4*)(bp + bj * HALF + 4); }
#pragma unroll
        for (int ai = 0; ai < 2; ++ai)
#pragma unroll
            for (int m = 0; m < 4; ++m) { const int row = row0 + ai * HALF + m * 16; bf16_t* rowp = O + (size_t)row * ldc + col0;
                const float rstd = __builtin_amdgcn_rsqf(rowss[row] * inv_nk + eps);
#pragma unroll
                for (int bj = 0; bj < 2; ++bj) { f32x4 v0 = acc[ai][bj][m][0] * rstd + bv[bj][0], v1 = acc[ai][bj][m][1] * rstd + bv[bj][1];
#pragma unroll
                    for (int e = 0; e < 4; ++e) { const float a0 = fmaxf(v0[e], 0.f), a1 = fmaxf(v1[e], 0.f); v0[e] = a0 * a0; v1[e] = a1 * a1; }
                    u32x4 w; w.x = cvt_pk_bf16(v0[0], v0[1]); w.y = cvt_pk_bf16(v0[2], v0[3]); w.z = cvt_pk_bf16(v1[0], v1[1]); w.w = cvt_pk_bf16(v1[2], v1[3]);
                    *(u32x4*)(rowp + bj * HALF) = w; } }
    }
};
__device__ __forceinline__ float bf_lo(unsigned u) { return __builtin_bit_cast(float, u << 16); }
__device__ __forceinline__ float bf_hi(unsigned u) { return __builtin_bit_cast(float, u & 0xffff0000u); }
template <bool NEXT> struct EpiRes {
    static constexpr bool PERM = true, AFTER_DRAIN = false;
    const float* base; const bf16_t* baseb; float* out; bf16_t* x1b; int ldc; const float* gate; int gstride; bf16_t* xn; const float* gmul; const float* scl; float* rowss;
    __device__ __forceinline__ void operator()(const f32x4 (&acc)[2][2][4][2], const Unit& u, int wr, int wc, int fr, int fq) const {
        const int row0 = u.pm * BM + wr * 64 + fr, col0 = u.pn * BM + wc * 32 + 8 * fq;
        const float* gp = gate + (size_t)(u.pm >> 3) * gstride + col0;
        f32x4 gv[2][2], mv[2][2];
#pragma unroll
        for (int bj = 0; bj < 2; ++bj)
#pragma unroll
            for (int n = 0; n < 2; ++n) { gv[bj][n] = *(const f32x4*)(gp + bj * HALF + n * 4);
                if (NEXT) mv[bj][n] = *(const f32x4*)(gmul + col0 + bj * HALF + n * 4) * (1.f + *(const f32x4*)(scl + (size_t)(u.pm >> 3) * gstride + col0 + bj * HALF + n * 4)); }
#pragma unroll
        for (int ai = 0; ai < 2; ++ai)
#pragma unroll
            for (int m = 0; m < 4; ++m) { const int row = row0 + ai * HALF + m * 16; const size_t off = (size_t)row * ldc + col0; float ss = 0.f;
#pragma unroll
                for (int bj = 0; bj < 2; ++bj) { f32x4 b0, b1;
                    if (NEXT) { b0 = __builtin_nontemporal_load((const f32x4*)(base + off + bj * HALF)); b1 = __builtin_nontemporal_load((const f32x4*)(base + off + bj * HALF + 4)); }
                    else { const u32x4 r = __builtin_nontemporal_load((const u32x4*)(baseb + off + bj * HALF)); b0 = (f32x4){bf_lo(r.x), bf_hi(r.x), bf_lo(r.y), bf_hi(r.y)}; b1 = (f32x4){bf_lo(r.z), bf_hi(r.z), bf_lo(r.w), bf_hi(r.w)}; }
                    const f32x4 o0 = b0 + gv[bj][0] * acc[ai][bj][m][0], o1 = b1 + gv[bj][1] * acc[ai][bj][m][1];
                    if (!NEXT) { __builtin_nontemporal_store(o0, (f32x4*)(out + off + bj * HALF)); __builtin_nontemporal_store(o1, (f32x4*)(out + off + bj * HALF + 4)); }
                    if (NEXT) { ss += (o0[0] * o0[0] + o0[1] * o0[1]) + (o0[2] * o0[2] + o0[3] * o0[3]) + (o1[0] * o1[0] + o1[1] * o1[1]) + (o1[2] * o1[2] + o1[3] * o1[3]);
                        u32x4 xw; xw.x = cvt_pk_bf16(o0[0], o0[1]); xw.y = cvt_pk_bf16(o0[2], o0[3]); xw.z = cvt_pk_bf16(o1[0], o1[1]); xw.w = cvt_pk_bf16(o1[2], o1[3]);
                        __builtin_nontemporal_store(xw, (u32x4*)(x1b + off + bj * HALF));
                        const f32x4 a0 = o0 * mv[bj][0], a1 = o1 * mv[bj][1];
                        u32x4 w; w.x = cvt_pk_bf16(a0[0], a0[1]); w.y = cvt_pk_bf16(a0[2], a0[3]); w.z = cvt_pk_bf16(a1[0], a1[1]); w.w = cvt_pk_bf16(a1[2], a1[3]);
                        *(u32x4*)(xn + off + bj * HALF) = w; } }
                if (NEXT) { ss += __shfl_xor(ss, 16); ss += __shfl_xor(ss, 32); if (fq == 0) atomicAdd(rowss + row, ss); }
                if (m & 1) asm volatile("" ::: "memory"); }
    }
};
template <class Epi, class Sched, bool ALIGN_EPI = false, bool SP2 = false>
__device__ __forceinline__ void gemm_phase(PG8_LAS unsigned char* lds, const Gemm g, const Sched& S, const Epi& E) {
    const int tid = threadIdx.x, wid = __builtin_amdgcn_readfirstlane(tid >> 6), lane = tid & 63, wr = wid >> 2, wc = wid & 3, fr = lane & 15, fq = lane >> 4;
    const int K = g.K, nt = K / BK;
    unsigned voffA[2], voffB[2];
#pragma unroll
    for (int i = 0; i < 2; ++i) { int R, C; stage_rc(tid * 16 + i * 8192, R, C); const int Rb = Epi::PERM ? ((R & ~31) + perm32(R & 31)) : R;
        voffA[i] = (unsigned)(R * K + C) * 2u; voffB[i] = (unsigned)(Rb * K + C) * 2u; }
    const size_t kstep = (size_t)(BK * 2);
    const size_t hstep = (size_t)HALF * K * 2;
    const size_t tstep = 2 * hstep;
    const unsigned ldsw = (unsigned)wid * 1024u;
    const int aoff = lds_byte(wr * 64 + fr, fq * 8), boff = lds_byte(wc * 32 + fr, fq * 8);
#define PG8_SA(b, h) (((b) * 2 + (h)) * HTB)
#define PG8_SB(b, h) ((4 + (b) * 2 + (h)) * HTB)
#define PG8_STAGE(bufoff, gbase, voff) do { _Pragma("unroll") for (int _i = 0; _i < 2; ++_i) \
        __builtin_amdgcn_global_load_lds((const unsigned*)((const char*)(gbase) + (voff)[_i]), (PG8_LAS unsigned*)(lds + (bufoff) + ldsw + _i * 8192), 16, 0, 0); } while (0)
#define PG8_LDA(dst, b, h) do { _Pragma("unroll") for (int m = 0; m < 4; ++m) _Pragma("unroll") for (int k = 0; k < 2; ++k) dst[m][k] = *(const PG8_LAS bf16x8*)(lds + PG8_SA(b, h) + aoff + m * 2048 + k * 1024); } while (0)
#define PG8_LDB(dst, b, h) do { _Pragma("unroll") for (int n = 0; n < 2; ++n) _Pragma("unroll") for (int k = 0; k < 2; ++k) dst[n][k] = *(const PG8_LAS bf16x8*)(lds + PG8_SB(b, h) + boff + n * 2048 + k * 1024); } while (0)
#define PG8_MMA(ai, bj, At, Bt) do { __builtin_amdgcn_s_setprio(1); _Pragma("unroll") for (int m = 0; m < 4; ++m) _Pragma("unroll") for (int n = 0; n < 2; ++n) _Pragma("unroll") for (int k = 0; k < 2; ++k) \
        acc[ai][bj][m][n] = __builtin_amdgcn_mfma_f32_16x16x32_bf16(Bt[n][k], At[m][k], acc[ai][bj][m][n], 0, 0, 0); __builtin_amdgcn_s_setprio(0); } while (0)
#define PG8_WAIT_V(n) asm volatile("s_waitcnt vmcnt(" #n ")" ::: "memory")
#define PG8_WAIT_L(n) asm volatile("s_waitcnt lgkmcnt(" #n ")" ::: "memory")
#define PG8_BAR __builtin_amdgcn_s_barrier()
#define PG8_SCHED __builtin_amdgcn_sched_barrier(0)
    Unit cur, nxt; int ui = 0;
    if (!S.next(0, cur)) return;
    f32x4 acc[2][2][4][2];
#pragma unroll
    for (int a = 0; a < 2; ++a)
#pragma unroll
        for (int b = 0; b < 2; ++b)
#pragma unroll
            for (int m = 0; m < 4; ++m)
#pragma unroll
                for (int n = 0; n < 2; ++n) acc[a][b][m][n] = (f32x4){0.f, 0.f, 0.f, 0.f};
    bf16x8 At[4][2], B0[2][2], B1[2][2];
    const char* cA = (const char*)g.A + (size_t)cur.pm * tstep; const char* cB = (const char*)g.Bt + (size_t)cur.pn * tstep;
    S.a_ready(cur);
    if constexpr (SP2) {
        PG8_STAGE(PG8_SB(0, 0), cB, voffB); PG8_STAGE(PG8_SB(0, 1), cB + hstep, voffB); PG8_STAGE(PG8_SA(0, 0), cA, voffA); PG8_STAGE(PG8_SA(0, 1), cA + hstep, voffA);
        if (wr == 1) PG8_BAR;
        PG8_WAIT_V(2); PG8_BAR;
        PG8_STAGE(PG8_SB(1, 0), cB + kstep, voffB); PG8_STAGE(PG8_SA(1, 0), cA + kstep, voffA); PG8_STAGE(PG8_SB(1, 1), cB + hstep + kstep, voffB);
        PG8_WAIT_V(6); PG8_BAR;
    } else {
        PG8_STAGE(PG8_SB(0, 0), cB, voffB); PG8_STAGE(PG8_SA(0, 0), cA, voffA); PG8_STAGE(PG8_SB(0, 1), cB + hstep, voffB); PG8_STAGE(PG8_SA(0, 1), cA + hstep, voffA);
        if (wr == 1) PG8_BAR;
        PG8_WAIT_V(4); PG8_BAR;
        PG8_STAGE(PG8_SB(1, 0), cB + kstep, voffB); PG8_STAGE(PG8_SA(1, 0), cA + kstep, voffA); PG8_STAGE(PG8_SB(1, 1), cB + hstep + kstep, voffB);
        PG8_WAIT_V(6); PG8_BAR;
    }
    for (;;) {
        const bool has_next = S.next(ui + 1, nxt);
        const char* nA = has_next ? (const char*)g.A + (size_t)nxt.pm * tstep : cA; const char* nB = has_next ? (const char*)g.Bt + (size_t)nxt.pn * tstep : cB;
        for (int t = 0; t < nt; t += 2) {
            const bool last = (t == nt - 2);
            const char* a1 = cA + (size_t)(t + 1) * kstep;
            const char* a2 = last ? nA : cA + (size_t)(t + 2) * kstep; const char* b2 = last ? nB : cB + (size_t)(t + 2) * kstep;
            const char* a3 = a2 + kstep; const char* b3 = b2 + kstep;
            if (last && has_next) S.a_ready(nxt);
            if constexpr (SP2) {
            PG8_LDB(B0, 0, 0); PG8_LDB(B1, 0, 1); PG8_SCHED; PG8_LDA(At, 0, 0); PG8_STAGE(PG8_SA(1, 1), a1 + hstep, voffA);
            PG8_WAIT_V(8); PG8_WAIT_L(0); PG8_BAR; PG8_MMA(0, 0, At, B0); PG8_MMA(0, 1, At, B1); PG8_BAR; PG8_SCHED;
            PG8_LDA(At, 0, 1); PG8_STAGE(PG8_SB(0, 0), b2, voffB); PG8_STAGE(PG8_SB(0, 1), b2 + hstep, voffB); PG8_STAGE(PG8_SA(0, 0), a2, voffA);
            PG8_WAIT_V(8); PG8_WAIT_L(0); PG8_BAR; PG8_MMA(1, 0, At, B0); PG8_MMA(1, 1, At, B1); PG8_BAR; PG8_SCHED;
            PG8_LDB(B0, 1, 0); PG8_LDB(B1, 1, 1); PG8_SCHED; PG8_LDA(At, 1, 0); PG8_STAGE(PG8_SA(0, 1), a2 + hstep, voffA);
            PG8_WAIT_V(8); PG8_WAIT_L(0); PG8_BAR; PG8_MMA(0, 0, At, B0); PG8_MMA(0, 1, At, B1); PG8_BAR; PG8_SCHED;
            PG8_LDA(At, 1, 1); PG8_STAGE(PG8_SB(1, 0), b3, voffB); PG8_STAGE(PG8_SB(1, 1), b3 + hstep, voffB); PG8_STAGE(PG8_SA(1, 0), a3, voffA);
            PG8_WAIT_V(8); PG8_WAIT_L(0); PG8_BAR; PG8_MMA(1, 0, At, B0); PG8_MMA(1, 1, At, B1); PG8_BAR; PG8_SCHED;
            } else {
            PG8_LDB(B0, 0, 0); PG8_SCHED; PG8_LDA(At, 0, 0); PG8_STAGE(PG8_SA(1, 1), a1 + hstep, voffA);
            PG8_WAIT_L(8); PG8_BAR; PG8_WAIT_L(0); PG8_MMA(0, 0, At, B0); PG8_BAR; PG8_SCHED;
            PG8_LDB(B1, 0, 1); PG8_STAGE(PG8_SB(0, 0), b2, voffB);
            PG8_BAR; PG8_WAIT_L(0); PG8_MMA(0, 1, At, B1); PG8_BAR;
            PG8_LDA(At, 0, 1); PG8_STAGE(PG8_SA(0, 0), a2, voffA);
            PG8_BAR; PG8_WAIT_L(0); PG8_MMA(1, 0, At, B0); PG8_BAR; PG8_SCHED;
            PG8_STAGE(PG8_SB(0, 1), b2 + hstep, voffB);
            PG8_WAIT_V(6); PG8_BAR; PG8_MMA(1, 1, At, B1); PG8_BAR;
            PG8_LDB(B0, 1, 0); PG8_SCHED; PG8_LDA(At, 1, 0); PG8_STAGE(PG8_SA(0, 1), a2 + hstep, voffA);
            PG8_WAIT_L(8); PG8_BAR; PG8_WAIT_L(0); PG8_MMA(0, 0, At, B0); PG8_BAR; PG8_SCHED;
            PG8_LDB(B1, 1, 1); PG8_STAGE(PG8_SB(1, 0), b3, voffB);
            PG8_BAR; PG8_WAIT_L(0); PG8_MMA(0, 1, At, B1); PG8_BAR;
            PG8_LDA(At, 1, 1); PG8_STAGE(PG8_SA(1, 0), a3, voffA);
            PG8_BAR; PG8_WAIT_L(0); PG8_MMA(1, 0, At, B0); PG8_BAR; PG8_SCHED;
            PG8_STAGE(PG8_SB(1, 1), b3 + hstep, voffB);
            PG8_WAIT_V(6); PG8_BAR; PG8_MMA(1, 1, At, B1); PG8_BAR;
            }
        }
        if constexpr (ALIGN_EPI) { if (wr == 0) PG8_BAR; }
        if constexpr (!Epi::AFTER_DRAIN) { E(acc, cur, wr, wc, fr, fq); S.done(cur); }
        if (!has_next) break;
#pragma unroll
        for (int a = 0; a < 2; ++a)
#pragma unroll
            for (int b = 0; b < 2; ++b)
#pragma unroll
                for (int m = 0; m < 4; ++m)
#pragma unroll
                    for (int n = 0; n < 2; ++n) acc[a][b][m][n] = (f32x4){0.f, 0.f, 0.f, 0.f};
        cur = nxt; cA = nA; cB = nB; ++ui;
        if constexpr (ALIGN_EPI) { if (wr == 1) PG8_BAR; }
    }
    PG8_WAIT_V(0);
    if constexpr (!ALIGN_EPI) { if (wr == 0) PG8_BAR; }
    PG8_BAR;
    if constexpr (Epi::AFTER_DRAIN) { E.fused(acc, cur, wr, wc, fr, fq, lds, wid, lane); S.done(cur); }
#undef PG8_SA
#undef PG8_SB
#undef PG8_STAGE
#undef PG8_LDA
#undef PG8_LDB
#undef PG8_MMA
#undef PG8_WAIT_V
#undef PG8_WAIT_L
#undef PG8_BAR
#undef PG8_SCHED
}
}
namespace att {
constexpr int D = 128, LDP = 5120, LDO = 2048, GL_OFF = 69632, QL_OFF = 81920; constexpr float THR = 8.f; constexpr bool WSKIP = false;
#ifdef NO_BIAS
#define BIAS_INIT(p0, p1, gt) do { p0 = f32x16{}; p1 = f32x16{}; } while (0)
#else
#define BIAS_INIT(p0, p1, gt) do { _Pragma("unroll") for (int i_ = 0; i_ < 4; ++i_) { const f32x4 g0_ = *(const f32x4*)((gt) + 8 * i_), g1_ = *(const f32x4*)((gt) + 32 + 8 * i_); p0[4 * i_] = g0_[0]; p0[4 * i_ + 1] = g0_[1]; p0[4 * i_ + 2] = g0_[2]; p0[4 * i_ + 3] = g0_[3]; p1[4 * i_] = g1_[0]; p1[4 * i_ + 1] = g1_[1]; p1[4 * i_ + 2] = g1_[2]; p1[4 * i_ + 3] = g1_[3]; } } while (0)
#endif
template <class A, class Bt> struct same_t { static constexpr bool v = false; };
template <class A> struct same_t<A, A> { static constexpr bool v = true; };
constexpr float SCALE = 0.08838834764831845f;
constexpr int NW = 8, QBLK = 32, KVBLK = 64, QB = NW * QBLK;
constexpr int SHM_V = KVBLK * D * 2, SHM_K = KVBLK * D * 2;
constexpr int LDS_BYTES = 2 * SHM_V + 2 * SHM_K + NW * 64 * 4;

using bf16 = __hip_bfloat16;
typedef short bf16x8 __attribute__((ext_vector_type(8)));
typedef short s16x4 __attribute__((ext_vector_type(4)));
typedef float f32x16 __attribute__((ext_vector_type(16)));
typedef float f32x4 __attribute__((ext_vector_type(4)));
typedef unsigned u32x4 __attribute__((ext_vector_type(4)));

#define KSWZ(row, colB) ((row) * 256 + ((colB) ^ (((row) & 7) << 4)))
#define SBAR() __builtin_amdgcn_sched_barrier(0)
__device__ __forceinline__ int v_st(int k, int c) { const int kk = (k & ~0xC) | ((k & 4) << 1) | ((k & 8) >> 1); return ((kk >> 3) * 4 + (c >> 5)) * 512 + ((kk & 7) * 32 + (c & 31)) * 2; }
__device__ __forceinline__ int v_rd_base(int lane) { return ((lane & 3) << 3) | (((lane >> 2) & 3) << 6) | (((lane >> 4) & 1) << 5) | (((lane >> 5) & 1) << 8); }
constexpr int v_rd_off(int d0, int ks, int half) { return d0 * 512 + ks * 4096 + half * 2048; }
__device__ __forceinline__ int crow(int r, int hi) { return (r & 3) + 8 * (r >> 2) + 4 * hi; }
__device__ __forceinline__ unsigned cvtpk(float lo, float hi) {
    unsigned r; asm volatile("v_cvt_pk_bf16_f32 %0, %1, %2" : "=v"(r) : "v"(lo), "v"(hi)); return r;
}
__device__ __forceinline__ bf16x8 pack8(f32x4 a, f32x4 b) {
    u32x4 w = {cvtpk(a[0], a[1]), cvtpk(a[2], a[3]), cvtpk(b[0], b[1]), cvtpk(b[2], b[3])};
    return *reinterpret_cast<bf16x8*>(&w);
}
template <class T> __device__ __forceinline__ bf16x8 load8(const T* p) {
    if constexpr (same_t<T, float>::v) { return pack8(*(const f32x4*)p, *(const f32x4*)(p + 4)); }
    else { return *reinterpret_cast<const bf16x8*>(p); }
}
__device__ __forceinline__ void mask_tile(f32x16& p0, f32x16& p1, int dq, unsigned W) {
    const float NEG = -__builtin_inff();
#pragma unroll
    for (int r = 0; r < 16; ++r) {
        const int c = (r & 3) + 8 * (r >> 2);
        if ((unsigned)(dq - c) >= W) p0[r] = NEG;
        if ((unsigned)(dq - c - 32) >= W) p1[r] = NEG;
    }
}
__device__ __forceinline__ void partialSM(f32x16& p0, f32x16& p1, float& m_reg, float& mn, float& alpha) {
    float pmax = p0[0]; for (int r = 1; r < 16; ++r) pmax = fmaxf(pmax, p0[r]); for (int r = 0; r < 16; ++r) pmax = fmaxf(pmax, p1[r]);
    { auto rr = __builtin_amdgcn_permlane32_swap(__float_as_uint(pmax), __float_as_uint(pmax), false, false);
      pmax = fmaxf(__uint_as_float(rr[0]), __uint_as_float(rr[1])); }
    constexpr float C2 = 1.4426950408889634f * SCALE;
    if (__builtin_expect(__all((pmax - m_reg) * SCALE <= THR), 1)) { mn = m_reg; alpha = 1.f; }
    else { mn = fmaxf(m_reg, pmax); alpha = __builtin_amdgcn_exp2f((m_reg - mn) * C2); m_reg = mn; }
    const float mnL = -mn * C2;
    for (int r = 0; r < 16; ++r) p0[r] = fmaf(p0[r], C2, mnL); for (int r = 0; r < 16; ++r) p1[r] = fmaf(p1[r], C2, mnL);
    for (int r = 0; r < 16; ++r) p0[r] = __builtin_amdgcn_exp2f(p0[r]);
}
__device__ __forceinline__ void finishSM(f32x16& p0, f32x16& p1, float alpha, float& l_reg, bf16x8& pa0, bf16x8& pa1, bf16x8& pa2, bf16x8& pa3) {
    for (int r = 0; r < 16; ++r) p1[r] = __builtin_amdgcn_exp2f(p1[r]);
    float ps = 0; for (int r = 0; r < 16; ++r) ps += p0[r]; for (int r = 0; r < 16; ++r) ps += p1[r];
    { auto rr = __builtin_amdgcn_permlane32_swap(__float_as_uint(ps), __float_as_uint(ps), false, false);
      ps = __uint_as_float(rr[0]) + __uint_as_float(rr[1]); }
    l_reg = l_reg * alpha + ps;
#define PK4(P, B_, OUT) do { unsigned a0 = cvtpk(P[B_+0], P[B_+1]), a1 = cvtpk(P[B_+2], P[B_+3]);                          \
        unsigned b0 = cvtpk(P[B_+4], P[B_+5]), b1 = cvtpk(P[B_+6], P[B_+7]);                                             \
        auto r0 = __builtin_amdgcn_permlane32_swap(a0, b0, false, false); auto r1 = __builtin_amdgcn_permlane32_swap(a1, b1, false, false); \
        u32x4 w = {r0[0], r1[0], r0[1], r1[1]}; OUT = *reinterpret_cast<bf16x8*>(&w); } while (0)
    PK4(p0, 0, pa0); PK4(p0, 8, pa1); PK4(p1, 0, pa2); PK4(p1, 8, pa3);
#undef PK4
}
template <int KB, bool SK>
__device__ __forceinline__ void qkt(f32x16& p0, f32x16& p1, const char* K_lds, int r32, int hi, const bf16x8* qr, bool act, const float* gt) {
    if (SK && !act) { const float NEG = -__builtin_inff();
#pragma unroll
        for (int r = 0; r < 16; ++r) { p0[r] = NEG; p1[r] = NEG; } return; }
    BIAS_INIT(p0, p1, gt);
    const char* kb[4];
#pragma unroll
    for (int dd = 0; dd < 4; ++dd) kb[dd] = K_lds + KB * SHM_K + KSWZ(r32, (dd * 16 + hi * 8) * 2);
#pragma unroll
    for (int d0 = 0; d0 < 8; ++d0) { const char* a = kb[d0 & 3] + (d0 >> 2) * 128;
        bf16x8 b0 = *reinterpret_cast<const bf16x8*>(a);
        bf16x8 b1 = *reinterpret_cast<const bf16x8*>(a + 32 * 256);
        { const bf16x8 qv_ = qr[d0 * 64]; p0 = __builtin_amdgcn_mfma_f32_32x32x16_bf16(b0, qv_, p0, 0, 0, 0);
        p1 = __builtin_amdgcn_mfma_f32_32x32x16_bf16(b1, qv_, p1, 0, 0, 0); } }
}
template <int VB, bool SK>
__device__ __forceinline__ void pv_tile(f32x16* o, int vb0, bf16x8 pa0, bf16x8 pa1, bf16x8 pa2, bf16x8 pa3, bool act) {
    if (SK && !act) return;
#define TRRD(dst, off) asm volatile("ds_read_b64_tr_b16 %0, %1 offset:%2" : "=&v"(dst) : "v"(vb0), "i"(off) : "memory")
#define PV_D0(d0) do { s16x4 l0, l1, l2, l3, h0, h1, h2, h3; constexpr int b_ = VB * SHM_V + v_rd_off(d0, 0, 0);     \
        TRRD(l0, b_); TRRD(h0, b_ + 2048); TRRD(l1, b_ + 4096); TRRD(h1, b_ + 6144); TRRD(l2, b_ + 8192); TRRD(h2, b_ + 10240); TRRD(l3, b_ + 12288); TRRD(h3, b_ + 14336); \
        asm volatile("s_waitcnt lgkmcnt(0)" ::: "memory"); SBAR();                 \
        o[d0] = __builtin_amdgcn_mfma_f32_32x32x16_bf16(pa0, (bf16x8){l0[0], l0[1], l0[2], l0[3], h0[0], h0[1], h0[2], h0[3]}, o[d0], 0, 0, 0);   \
        o[d0] = __builtin_amdgcn_mfma_f32_32x32x16_bf16(pa1, (bf16x8){l1[0], l1[1], l1[2], l1[3], h1[0], h1[1], h1[2], h1[3]}, o[d0], 0, 0, 0);   \
        o[d0] = __builtin_amdgcn_mfma_f32_32x32x16_bf16(pa2, (bf16x8){l2[0], l2[1], l2[2], l2[3], h2[0], h2[1], h2[2], h2[3]}, o[d0], 0, 0, 0);   \
        o[d0] = __builtin_amdgcn_mfma_f32_32x32x16_bf16(pa3, (bf16x8){l3[0], l3[1], l3[2], l3[3], h3[0], h3[1], h3[2], h3[3]}, o[d0], 0, 0, 0); } while (0)
    PV_D0(0); PV_D0(1); PV_D0(2); PV_D0(3);
#undef PV_D0
#undef TRRD
}

template <class TIn, class TOut> struct BlockRef { const TIn* B; TOut* OB; int P0;
    __device__ __forceinline__ const TIn* Q() const { return B + (size_t)P0 * LDP; } __device__ __forceinline__ const TIn* K() const { return B + 1024; } __device__ __forceinline__ const TIn* V() const { return B + 2048; }
    __device__ __forceinline__ TOut* O() const { return OB + (size_t)P0 * LDO; } };
template <class TIn> struct Seam {
    bf16x8 qr[8];
    bf16x8 st_v0, st_v1, st_k0, st_k1; f32x4 sf0, sf1, sf2, sf3;
    f32x4 tq[16];
};
__device__ __forceinline__ int swa_jlo(int P0, int W) { const int lowk = P0 - W + 1; return lowk > 0 ? lowk / KVBLK : 0; }
#define ROW(p, k0, rr) ((p) + (size_t)((k0) + (rr)) * LDP + sc)
#define VMW() asm volatile("s_waitcnt vmcnt(0)" ::: "memory")
#define VMWN(n) asm volatile("s_waitcnt vmcnt(%0)" :: "i"(n) : "memory")
#define SLOAD_H(Kp, Vp, k0) do { S.st_v0 = load8<TIn>(ROW(Vp, k0, sr)); S.st_v1 = load8<TIn>(ROW(Vp, k0, 32 + sr));              \
                         S.st_k0 = load8<TIn>(ROW(Kp, k0, sr)); S.st_k1 = load8<TIn>(ROW(Kp, k0, 32 + sr)); } while (0)
#define SWRITE_HK(bf) do { *(bf16x8*)(K_lds + (bf) * SHM_K + kws) = S.st_k0; *(bf16x8*)(K_lds + (bf) * SHM_K + kws + 32 * 256) = S.st_k1; } while (0)
#define SWRITE_HV(bf) do { *(bf16x8*)(V_lds + (bf) * SHM_V + vst0) = S.st_v0; *(bf16x8*)(V_lds + (bf) * SHM_V + vst1) = S.st_v1; } while (0)
#define SWRITE_H(bf) do { SWRITE_HV(bf); SWRITE_HK(bf); } while (0)
#define SLOAD_F(p, k0) do { S.sf0 = *(const f32x4*)ROW(p, k0, sr); S.sf1 = *(const f32x4*)(ROW(p, k0, sr) + 4);                \
                            S.sf2 = *(const f32x4*)ROW(p, k0, 32 + sr); S.sf3 = *(const f32x4*)(ROW(p, k0, 32 + sr) + 4); } while (0)
#define SWRITE_KF(bf) do { *(bf16x8*)(K_lds + (bf) * SHM_K + kws) = pack8(S.sf0, S.sf1); *(bf16x8*)(K_lds + (bf) * SHM_K + kws + 32 * 256) = pack8(S.sf2, S.sf3); } while (0)
#define SWRITE_VF(bf) do { *(bf16x8*)(V_lds + (bf) * SHM_V + vst0) = pack8(S.sf0, S.sf1); *(bf16x8*)(V_lds + (bf) * SHM_V + vst1) = pack8(S.sf2, S.sf3); } while (0)
template <class TIn, class TOut>
__device__ __forceinline__ void causal_swa_prime(const BlockRef<TIn, TOut>& cur, int W, char* lds, Seam<TIn>& S) {
    constexpr bool F32 = same_t<TIn, float>::v;
    int tid = threadIdx.x; asm volatile("" : "+v"(tid)); const int wid = __builtin_amdgcn_readfirstlane(tid >> 6), lane = tid & 63, r32 = lane & 31, hi = lane >> 5;
    const int sr = tid >> 4, sc = (tid & 15) * 8, kws = KSWZ(sr, sc * 2); char* K_lds = lds + 2 * SHM_V;
    const int kb0 = swa_jlo(cur.P0, W) * KVBLK;
    if constexpr (F32) { SLOAD_F((const float*)cur.K(), kb0); VMW(); SWRITE_KF(0); SBAR(); SLOAD_F((const float*)cur.V(), kb0); }
    else { SLOAD_H(cur.K(), cur.V(), kb0); VMW(); SWRITE_HK(0); }
    __syncthreads();
}
template <class TIn, class TOut>
__device__ __forceinline__ void causal_swa_block(const BlockRef<TIn, TOut>& cur, const BlockRef<TIn, TOut>& nxt, int skv, int W, char* lds, Seam<TIn>& S) {
    constexpr bool F32 = same_t<TIn, float>::v;
    int tid = threadIdx.x; asm volatile("" : "+v"(tid)); const int wid = __builtin_amdgcn_readfirstlane(tid >> 6), lane = tid & 63, r32 = lane & 31, hi = lane >> 5;
    const int j_lo = swa_jlo(cur.P0, W);
    int j_hi = (cur.P0 + QB - 1) / KVBLK + 1; if (j_hi > skv / KVBLK) j_hi = skv / KVBLK;
    const int NT = j_hi - j_lo;
    const int kbn = swa_jlo(nxt.P0, W) * KVBLK;
    const int qlo = cur.P0 + wid * QBLK, qm = qlo + r32 - 4 * hi;
    char* V_lds = lds; char* K_lds = lds + 2 * SHM_V; const float* Gl = (const float*)(lds + GL_OFF);
    float* ws = (float*)(lds + 2 * SHM_V + 2 * SHM_K) + wid * 64; float* li_l = ws, * al_l = ws + 32;
    float m_reg = -1e30f, l_reg = 0; f32x16 o[4] = {};
    const int sr = tid >> 4, sc = (tid & 15) * 8, vst0 = v_st(sr, sc), vst1 = v_st(32 + sr, sc), kws = KSWZ(sr, sc * 2);
    const int vb0 = (int)(uintptr_t)V_lds + v_rd_base(lane);
    const TIn* Kh = cur.K(); const TIn* Vh = cur.K() + 1024;
    bf16x8* QLp = (bf16x8*)(lds + QL_OFF + wid * 8192) + lane;
    if constexpr (F32) { for (int d0 = 0; d0 < 8; ++d0) QLp[d0 * 64] = S.qr[d0]; }
    else { bf16x8 qt[8];
#pragma unroll
        for (int d0 = 0; d0 < 8; ++d0) qt[d0] = load8<TIn>(cur.Q() + (size_t)(wid * QBLK + r32) * LDP + d0 * 16 + hi * 8);
#pragma unroll
        for (int d0 = 0; d0 < 8; ++d0) QLp[d0 * 64] = qt[d0]; }
    SBAR();
#define RESC(a) do { if (__any((a) < 1.f)) { if (hi == 0) al_l[r32] = (a); asm volatile("s_waitcnt lgkmcnt(0)" ::: "memory");              \
                     for (int d_ = 0; d_ < 4; ++d_) for (int r = 0; r < 16; ++r) o[d_][r] *= al_l[crow(r, hi)]; } } while (0)
#define KBASE(t) ((j_lo + (t)) * KVBLK)
#define ACT(t) (KBASE(t) <= qlo + QBLK - 1 && KBASE(t) + KVBLK - 1 >= qlo - W + 1)
#define MASKT(P0_, P1_, t) do { const int kb_ = KBASE(t); if ((!SK || ACT(t)) && (kb_ + KVBLK - 1 > qlo || kb_ <= qlo + QBLK - 1 - W)) mask_tile(P0_, P1_, qm - kb_, (unsigned)W); } while (0)
    constexpr int NQL = F32 ? 16 : 0;
    constexpr bool SK = WSKIP && !F32;
#define SEAM_K0() do { VMWN(NQL); if constexpr (F32) { SWRITE_KF(0); SBAR(); SLOAD_F((const float*)nxt.V(), kbn); } else { SWRITE_HK(0); } SBAR(); } while (0)
    f32x16 pA0, pA1, pB0, pB1; float mnA, mnB, alA, alB; bf16x8 pa0, pa1, pa2, pa3;
    if constexpr (F32) { VMW(); SWRITE_VF(0); SBAR(); } else { SWRITE_HV(0); SBAR(); }
    if (NT > 1) { if constexpr (F32) SLOAD_F((const float*)Kh, KBASE(1)); else SLOAD_H(Kh, Vh, KBASE(1)); }
    SBAR(); qkt<0, SK>(pA0, pA1, K_lds, r32, hi, QLp, ACT(0), Gl + KBASE(0) + 4 * hi);
    if constexpr (F32) { if (NT > 1) { VMW(); SWRITE_KF(1); SBAR(); SLOAD_F((const float*)Vh, KBASE(1)); } }
    MASKT(pA0, pA1, 0); partialSM(pA0, pA1, m_reg, mnA, alA);
    if (NT > 1) { VMW(); if constexpr (F32) { SWRITE_VF(1); SBAR(); if (NT > 2) SLOAD_F((const float*)Kh, KBASE(2)); } else SWRITE_H(1); }
    __syncthreads();
#define HALF_STEP(PX0, PX1, mnX, alX, PY0, PY1, alY, t, KB, VB, SB) do {                                                      \
        SBAR(); qkt<KB, SK>(PX0, PX1, K_lds, r32, hi, QLp, ACT(t), Gl + KBASE(t) + 4 * hi);                                             \
        finishSM(PY0, PY1, alY, l_reg, pa0, pa1, pa2, pa3); SBAR();                                                           \
        if ((t) + 1 < NT) { if constexpr (F32) { VMW(); SWRITE_KF(SB); SBAR(); SLOAD_F((const float*)Vh, KBASE((t) + 1)); }  \
                            else { SLOAD_H(Kh, Vh, KBASE((t) + 1)); } SBAR(); }                                               \
        pv_tile<VB, SK>(o, vb0, pa0, pa1, pa2, pa3, ACT((t) - 1)); MASKT(PX0, PX1, (t)); partialSM(PX0, PX1, m_reg, mnX, alX);                                        \
        __syncthreads();                                                                                                      \
        if ((t) + 1 < NT) { VMW(); if constexpr (F32) { SWRITE_VF(SB); SBAR(); if ((t) + 2 < NT) SLOAD_F((const float*)Kh, KBASE((t) + 2)); } \
                            else { SWRITE_H(SB); } }                                                                          \
        RESC(alX); __syncthreads(); } while (0)
    for (int t = 1; t + 1 < NT; t += 2) {
        HALF_STEP(pB0, pB1, mnB, alB, pA0, pA1, alA, t, 1, 0, 0);
        HALF_STEP(pA0, pA1, mnA, alA, pB0, pB1, alB, t + 1, 0, 1, 1);
    }
    const bool even = (NT & 1) == 0;
    if (even) { SBAR(); qkt<1, SK>(pB0, pB1, K_lds, r32, hi, QLp, ACT(NT - 1), Gl + KBASE(NT - 1) + 4 * hi); SBAR(); }
#define QROW(e) (nxt.Q() + (size_t)(wid * QBLK + r32) * LDP + ((e) >> 1) * 16 + hi * 8 + ((e) & 1) * 4)
    if constexpr (F32) { SLOAD_F((const float*)nxt.K(), kbn); SBAR();
#pragma unroll
        for (int e = 0; e < 8; ++e) S.tq[e] = *(const f32x4*)QROW(e); }
    else { SLOAD_H(nxt.K(), nxt.V(), kbn); SBAR(); }
    SBAR();
    finishSM(pA0, pA1, alA, l_reg, pa0, pa1, pa2, pa3); SBAR();
    if constexpr (F32) {
#pragma unroll
        for (int e = 8; e < 16; ++e) S.tq[e] = *(const f32x4*)QROW(e); SBAR(); }
#undef QROW
    pv_tile<0, SK>(o, vb0, pa0, pa1, pa2, pa3, ACT(even ? NT - 2 : NT - 1));
    if (even) { MASKT(pB0, pB1, NT - 1); partialSM(pB0, pB1, m_reg, mnB, alB); __syncthreads(); RESC(alB);
        finishSM(pB0, pB1, alB, l_reg, pa0, pa1, pa2, pa3); SBAR(); pv_tile<1, SK>(o, vb0, pa0, pa1, pa2, pa3, ACT(NT - 1)); }
    SBAR(); SEAM_K0();
    if (hi == 0) li_l[r32] = l_reg; asm volatile("s_waitcnt lgkmcnt(0)" ::: "memory");
    float rli[16];
#pragma unroll
    for (int r = 0; r < 16; ++r) rli[r] = __builtin_amdgcn_rcpf(li_l[crow(r, hi)]);
    TOut* Ow = cur.O() + (size_t)(wid * QBLK) * LDO;
#pragma unroll
    for (int r = 0; r < 16; ++r) { const int orow = crow(r, hi);
#pragma unroll
        for (int d0 = 0; d0 < 4; ++d0) { const float v = o[d0][r] * rli[r];
            if constexpr (same_t<TOut, float>::v) { Ow[(size_t)orow * LDO + d0 * 32 + r32] = v; }
            else { const float vn = __shfl_xor(v, 1);
                   if ((r32 & 1) == 0) *(unsigned*)(Ow + (size_t)orow * LDO + d0 * 32 + r32) = cvtpk(v, vn); } } }
    if constexpr (F32) {
#pragma unroll
        for (int d0 = 0; d0 < 8; ++d0) S.qr[d0] = pack8(S.tq[2 * d0], S.tq[2 * d0 + 1]); }
    __syncthreads();
#undef RESC
#undef KBASE
#undef ACT
#undef MASKT
#undef SEAM_K0
#undef HALF_STEP
}
#undef ROW
#undef VMW
#undef VMWN
#undef SLOAD_H
#undef SWRITE_HK
#undef SWRITE_HV
#undef SWRITE_H
#undef SLOAD_F
#undef SWRITE_KF
#undef SWRITE_VF

}
constexpr int NWAVES = 8;
constexpr int BATCH = 8, SEQ = 2048, DM = 2048, M = BATCH * SEQ, NH = 8, HD = 128, NGRP = 8, GC = 128, DFF = 8192, INCOLS = 5128, NP = 5120, NMODC = 12288;
constexpr float EPS = 1e-6f;
#ifndef MK_PER_PHASE
#define MK_PER_PHASE 0
#endif
constexpr int NPHASE = 7;
constexpr size_t MiB = 1u << 20;
constexpr size_t WS_PART = 0;
constexpr size_t WS_MOD = 2 * MiB;
constexpr size_t WS_TS = 2 * MiB + 768 * 1024;
constexpr size_t WS_WF = 2 * MiB + 512 * 1024;
constexpr size_t WS_ROWSS = WS_WF + 65536;
constexpr size_t WS_BIAS2 = 3 * MiB + 512 * 1024;
constexpr size_t WS_BAR = 2 * MiB + 768 * 1024 + 4096, WS_BAR_BYTES = 16384;
constexpr size_t WS_LS = 3 * MiB;
constexpr size_t WS_WIN = 4 * MiB, WS_WOUT = 24 * MiB, WS_WFF1 = 32 * MiB, WS_WFF2 = 64 * MiB;
constexpr size_t WS_H = 96 * MiB;
constexpr size_t WS_PROJ = 160 * MiB;
constexpr size_t WS_CAT = 320 * MiB;
constexpr size_t WS_A = 160 * MiB;
constexpr size_t WS_X1B = 416 * MiB;
constexpr size_t WS_END = 480 * MiB;
constexpr int RING_BYTES = 131072, XB_LDS_OFF = 147456, LDS_BYTES = 147456 + 64;

#define LAS __attribute__((address_space(3)))
typedef unsigned short bf16;
typedef unsigned v4u __attribute__((ext_vector_type(4)));
typedef unsigned v2u __attribute__((ext_vector_type(2)));
typedef float f32x4 __attribute__((ext_vector_type(4)));
typedef float f32x16 __attribute__((ext_vector_type(16)));
typedef short bf16x8 __attribute__((ext_vector_type(8)));
#define LDS_WAIT() asm volatile("s_waitcnt lgkmcnt(0)" ::: "memory")
__device__ __forceinline__ unsigned f2bf(float f) { unsigned u = __builtin_bit_cast(unsigned, f); return (u + 0x7fffu + ((u >> 16) & 1u)) >> 16; }
typedef float f32x2_t __attribute__((ext_vector_type(2))); typedef __bf16 bf16x2_t __attribute__((ext_vector_type(2)));
__device__ __forceinline__ unsigned pk2(float lo, float hi) { const f32x2_t v = {lo, hi}; const bf16x2_t b = __builtin_convertvector(v, bf16x2_t); return __builtin_bit_cast(unsigned, b); }
__device__ __forceinline__ float bflo(unsigned u) { return __builtin_bit_cast(float, u << 16); }
__device__ __forceinline__ float bfhi(unsigned u) { return __builtin_bit_cast(float, u & 0xffff0000u); }
__device__ __forceinline__ float dpp_add(float v, int ctrl) { return v; }
#define DPP_ADD(v, ctrl) ((v) + __builtin_bit_cast(float, __builtin_amdgcn_update_dpp(0, __builtin_bit_cast(int, (v)), (ctrl), 0xF, 0xF, true)))
__device__ __forceinline__ float xrow_sum(float v) {
    { const auto r = __builtin_amdgcn_permlane16_swap(__builtin_bit_cast(unsigned, v), __builtin_bit_cast(unsigned, v), false, false); v = __builtin_bit_cast(float, r[0]) + __builtin_bit_cast(float, r[1]); }
    { const auto r = __builtin_amdgcn_permlane32_swap(__builtin_bit_cast(unsigned, v), __builtin_bit_cast(unsigned, v), false, false); v = __builtin_bit_cast(float, r[0]) + __builtin_bit_cast(float, r[1]); }
    return v;
}
#define DPP_ADD(v, ctrl) ((v) + __builtin_bit_cast(float, __builtin_amdgcn_update_dpp(0, __builtin_bit_cast(int, (v)), (ctrl), 0xF, 0xF, true)))
__device__ __forceinline__ float wave_sum(float v) {
    v = DPP_ADD(v, 0xB1);
    v = DPP_ADD(v, 0x4E);
    v = DPP_ADD(v, 0x141);
    v = DPP_ADD(v, 0x140);
    v += __shfl_xor(v, 16); v += __shfl_xor(v, 32);
    return v;
}
struct Args { const float* in[16]; float* out; unsigned char* ws; int ph_lo, ph_hi; };
typedef const __attribute__((address_space(4))) Args* KA;

#define PHASE_IDS() int tid = threadIdx.x; asm volatile("" : "+v"(tid)); const int lane = tid & 63, wave = __builtin_amdgcn_readfirstlane(tid >> 6); \
    int G = gridDim.x, bx = blockIdx.x; asm volatile("" : "+s"(G), "+s"(bx)); const int vcu = (G % 8 == 0) ? (bx % 8) * (G / 8) + bx / 8 : bx; (void)lane; (void)wave; (void)vcu
struct TItem { const float* src; bf16* dst; int K, Nsrc, nt; };
__device__ __forceinline__ TItem t_decode(KA a, int it) {
    constexpr int I_IN = (DM / 64) * (NP / 64), I_OUT = (DM / 64) * (DM / 64), I_F1 = (DM / 64) * (DFF / 64);
    const float* W; bf16* WT; int K, Nsrc, nblk, shift_from = 1 << 30; int r = it;
    if (r < I_IN) { W = a->in[5]; WT = (bf16*)(a->ws + WS_WIN); K = DM; Nsrc = INCOLS; nblk = NP / 64; shift_from = 3072; }
    else if ((r -= I_IN) < I_OUT) { W = a->in[12]; WT = (bf16*)(a->ws + WS_WOUT); K = DM; Nsrc = DM; nblk = DM / 64; }
    else if ((r -= I_OUT) < I_F1) { W = a->in[14]; WT = (bf16*)(a->ws + WS_WFF1); K = DM; Nsrc = DFF; nblk = DFF / 64; }
    else { r -= I_F1; W = a->in[15]; WT = (bf16*)(a->ws + WS_WFF2); K = DFF; Nsrc = DM; nblk = DM / 64; }
    const int kb = r / nblk, nb = r % nblk, k0 = 64 * kb, n0 = 64 * nb, c0 = n0 + (n0 >= shift_from ? 8 : 0);
    TItem t; t.src = W + (size_t)k0 * Nsrc + c0; t.dst = WT + (size_t)n0 * K + k0; t.K = K; t.Nsrc = Nsrc; t.nt = (W == a->in[15]); return t;
}
__device__ __forceinline__ void t_load(f32x4 (&v)[16], const TItem& t, int lane) {
    const int r = lane >> 4, c4 = (lane & 15) * 4;
#pragma unroll
    for (int i = 0; i < 16; ++i) v[i] = __builtin_nontemporal_load((const f32x4*)(t.src + (size_t)(4 * i + r) * t.Nsrc + c4));
}
__device__ __forceinline__ void t_finish(const f32x4 (&v)[16], const TItem& t, LAS float* scr, int lane) {
    const int r = lane >> 4, c4 = (lane & 15) * 4;
#pragma unroll
    for (int i = 0; i < 16; ++i) { LAS float* s = scr + (4 * i + r) * 65 + c4; s[0] = v[i][0]; s[1] = v[i][1]; s[2] = v[i][2]; s[3] = v[i][3]; }
    LDS_WAIT(); asm volatile("" ::: "memory");
    const int c = lane & 7;
#pragma unroll
    for (int j = 0; j < 8; ++j) { const int n = (lane >> 3) + 8 * j; const LAS float* s = scr + (8 * c) * 65 + n;
        v4u o; o.x = pk2(s[0 * 65], s[1 * 65]); o.y = pk2(s[2 * 65], s[3 * 65]); o.z = pk2(s[4 * 65], s[5 * 65]); o.w = pk2(s[6 * 65], s[7 * 65]);
        if (t.nt) __builtin_nontemporal_store(o, (v4u*)(t.dst + (size_t)n * t.K + 8 * c)); else *(v4u*)(t.dst + (size_t)n * t.K + 8 * c) = o; }
    LDS_WAIT(); asm volatile("" ::: "memory");
}

__device__ __forceinline__ void t_run(KA a, LAS float* scr, int it0, int step, int cnt, int lane) {
    if (cnt > 0) {
        f32x4 va[16], vb[16]; TItem ta = t_decode(a, it0), tb = ta; t_load(va, ta, lane);
#pragma unroll 1
        for (int i = 0; i < cnt; ++i) {
            if (i + 1 < cnt) { tb = t_decode(a, it0 + (i + 1) * step); t_load(vb, tb, lane); }
            t_finish(va, ta, scr, lane);
            ta = tb;
#pragma unroll
            for (int q = 0; q < 16; ++q) va[q] = vb[q];
        }
    }
}

__device__ __forceinline__ void p0_phase(LAS unsigned char* lds, KA a) {
    PHASE_IDS();
    float* part = (float*)(a->ws + WS_PART);
    for (int u = vcu; u < 192; u += G) {
        const int cgp = u % 48, kq = u / 48, k0 = kq * 512 + wave * 64;
        LAS float* sc = (LAS float*)(lds + 65536 + wave * 2048);
        const float* c = a->in[1];
        for (int i = lane; i < 512; i += 64) { const int kk = i >> 3, b = i & 7; const float cv = c[b * DM + k0 + kk]; sc[i] = cv / (1.f + __expf(-cv)); }
        LDS_WAIT(); asm volatile("" ::: "memory");
        f32x4 acc[8];
#pragma unroll
        for (int b = 0; b < 8; ++b) acc[b] = (f32x4){0.f, 0.f, 0.f, 0.f};
        const float* wp = a->in[2] + (size_t)k0 * NMODC + cgp * 256 + lane * 4;
#pragma unroll 16
        for (int kk = 0; kk < 64; ++kk) { const f32x4 w = __builtin_nontemporal_load((const f32x4*)(wp + (size_t)kk * NMODC));
            const f32x4 s0 = *(const LAS f32x4*)(sc + kk * 8), s1 = *(const LAS f32x4*)(sc + kk * 8 + 4);
            acc[0] += s0[0] * w; acc[1] += s0[1] * w; acc[2] += s0[2] * w; acc[3] += s0[3] * w;
            acc[4] += s1[0] * w; acc[5] += s1[1] * w; acc[6] += s1[2] * w; acc[7] += s1[3] * w; }
        LAS float* red = (LAS float*)(lds + wave * 8192);
#pragma unroll
        for (int b = 0; b < 8; ++b) *(LAS f32x4*)(red + b * 256 + lane * 4) = acc[b];
        __syncthreads();
#pragma unroll
        for (int i = 0; i < 4; ++i) { const int o = tid + 512 * i; float s = 0.f;
#pragma unroll
            for (int w = 0; w < 8; ++w) s += ((const LAS float*)(lds + w * 8192))[o];
            part[(size_t)kq * (8 * NMODC) + (o >> 8) * NMODC + cgp * 256 + (o & 255)] = s; }
        __syncthreads();
    }
    LAS float* scr = (LAS float*)(lds + wave * 16640);
    constexpr int NITEMS = (DM / 64) * (NP / 64) + (DM / 64) * (DM / 64);
    static_assert(NITEMS == 192 * 7 + 64 * 35, "item split");
    int it0, cnt, step;
    if (G == 256) { const int b0 = vcu < 192 ? vcu * 7 : 192 * 7 + (vcu - 192) * 35, bc = vcu < 192 ? 7 : 35;
        it0 = b0 + wave; step = NWAVES; cnt = (bc - wave + NWAVES - 1) / NWAVES; }
    else { it0 = vcu * NWAVES + wave; step = G * NWAVES; cnt = it0 < NITEMS ? (NITEMS - it0 + step - 1) / step : 0; }
    t_run(a, scr, it0, step, cnt, lane);
    for (int i = vcu * 512 + tid; i < 8 * DM; i += G * 512) { const int k = i >> 3, h = i & 7; ((float*)(a->ws + WS_WF))[h * DM + k] = a->in[5][(size_t)k * INCOLS + 3072 + h]; }
    for (int i = vcu * 512 + tid; i < M; i += G * 512) ((float*)(a->ws + WS_ROWSS))[i] = 0.f;
}

__device__ __forceinline__ void load_row(f32x4 (&v)[8], const float* xrow, int lane) {
    const f32x4* xr = (const f32x4*)xrow + lane;
#pragma unroll
    for (int j = 0; j < 8; ++j) v[j] = __builtin_nontemporal_load(xr + 64 * j);
}
template <bool FL>
__device__ __forceinline__ void norm_row(const f32x4 (&v)[8], bf16* orow, const LAS float* gm, const LAS float* sh, const LAS float* wf, const float* b_f, float* lsrow, int lane) {
    float ss = 0.f;
#pragma unroll
    for (int j = 0; j < 8; ++j) ss += (v[j][0] * v[j][0] + v[j][1] * v[j][1]) + (v[j][2] * v[j][2] + v[j][3] * v[j][3]);
    const float rstd = __builtin_amdgcn_rsqf(wave_sum(ss) * (1.f / DM) + EPS);
    float fl[8];
#pragma unroll
    for (int h = 0; h < 8; ++h) fl[h] = 0.f;
    v2u* o8 = (v2u*)orow + lane;
#pragma unroll
    for (int j = 0; j < 8; ++j) { const f32x4 g = *(const LAS f32x4*)(gm + 4 * lane + 256 * j), s = *(const LAS f32x4*)(sh + 4 * lane + 256 * j);
        const f32x4 hv = v[j] * rstd * g + s;
        v2u w; w.x = pk2(hv[0], hv[1]); w.y = pk2(hv[2], hv[3]); o8[64 * j] = w;
        if (FL) {
#pragma unroll
            for (int h = 0; h < 8; ++h) { const f32x4 wv = *(const LAS f32x4*)(wf + h * DM + 4 * lane + 256 * j); fl[h] += (hv[0] * wv[0] + hv[1] * wv[1]) + (hv[2] * wv[2] + hv[3] * wv[3]); }
            asm volatile("" ::: "memory"); } }
    if (FL) {
#pragma unroll
        for (int h = 0; h < 8; ++h) fl[h] = wave_sum(fl[h]);
        float z = fl[0];
#pragma unroll
        for (int h = 1; h < 8; ++h) z = (lane == h) ? fl[h] : z;
        if (lane < 8) { z += b_f[lane]; lsrow[lane] = fminf(z, 0.f) - log1pf(__expf(-fabsf(z))); }
    }
}

__device__ __forceinline__ void p1_phase(LAS unsigned char* lds, KA a) {
    PHASE_IDS();
    const float* part = (const float*)(a->ws + WS_PART); float* mod = (float*)(a->ws + WS_MOD); const float* b_ada = a->in[3];
    LAS float* wf = (LAS float*)lds; LAS float* gm = (LAS float*)(lds + 65536); LAS float* sh = (LAS float*)(lds + 73728);
    for (int i = tid; i < 8 * DM / 4; i += 512) *(LAS f32x4*)(wf + 4 * i) = *(const f32x4*)((const float*)(a->ws + WS_WF) + 4 * i);
    for (int idx = vcu * 512 + tid; idx < 8 * NMODC; idx += G * 512) { float s = b_ada[idx % NMODC];
#pragma unroll
        for (int q = 0; q < 4; ++q) s += part[(size_t)q * (8 * NMODC) + idx];
        mod[idx] = s; }
    for (int ch = vcu; ch < M / 64; ch += G) {
        const int b = ch >> 5;
        __syncthreads();
        for (int j = tid; j < DM; j += 512) { float s0 = b_ada[j], s1 = b_ada[DM + j];
#pragma unroll
            for (int q = 0; q < 4; ++q) { s0 += part[(size_t)q * (8 * NMODC) + b * NMODC + j]; s1 += part[(size_t)q * (8 * NMODC) + b * NMODC + DM + j]; }
            sh[j] = s0; gm[j] = a->in[4][j] * (1.f + s1); }
        __syncthreads();
        f32x4 v[8], n1[8], n2[8];
        const float* xb = a->in[0] + (size_t)(ch * 64 + wave * 8) * DM;
        load_row(v, xb, lane); load_row(n1, xb + DM, lane);
#pragma unroll 1
        for (int r = 0; r < 8; ++r) { const int m = ch * 64 + wave * 8 + r, r2 = r + 2 < 8 ? r + 2 : 7;
            load_row(n2, xb + (size_t)r2 * DM, lane);
            norm_row<true>(v, (bf16*)(a->ws + WS_H) + (size_t)m * DM, gm, sh, wf, a->in[6], (float*)(a->ws + WS_LS) + (size_t)m * 8, lane);
#pragma unroll
            for (int j = 0; j < 8; ++j) { v[j] = n1[j]; n1[j] = n2[j]; } }
    }
}
constexpr int SG_LDW = 136;
__device__ __forceinline__ void sgu_load_v(v4u (&v)[4], KA a, int item, int tid) {
    const int b = item >> 7, n = (item >> 3) & 15, g = item & 7, tok0 = b * SEQ + n * 128, tl = tid >> 2, q4 = tid & 3;
    const bf16* vp = (const bf16*)(a->ws + WS_PROJ) + (size_t)(tok0 + tl) * NP + 4096 + g * 128 + q4 * 32;
#pragma unroll
    for (int i = 0; i < 4; ++i) v[i] = *(const v4u*)(vp + 8 * i);
}
__device__ __forceinline__ void sgu_item(LAS unsigned char* lds, KA a, int item, int next_item, v4u (&vr)[4], int tid, int lane, int wave) {
    const int b = item >> 7, n = (item >> 3) & 15, g = item & 7, tok0 = b * SEQ + n * 128;
    const bf16* proj = (const bf16*)(a->ws + WS_PROJ); bf16* cat = (bf16*)(a->ws + WS_CAT);
    LAS bf16* vnT = (LAS bf16*)lds;
    const int tb = wave & 3, chh = wave >> 2, j = lane & 31, hi = lane >> 5; int t = tb * 32 + j, nks = 2 * (tb + 1);
    asm volatile("" : "+v"(t), "+s"(nks));
    const bf16* up = proj + (size_t)(tok0 + t) * NP + 3072 + g * 128 + chh * 64 + 4 * hi;
    v2u uu[2][4];
#pragma unroll
    for (int ct = 0; ct < 2; ++ct)
#pragma unroll
        for (int rg = 0; rg < 4; ++rg) uu[ct][rg] = *(const v2u*)(up + ct * 32 + 8 * rg);
    const float bs = a->in[11][g * 128 + t];
    v4u vcur[4];
#pragma unroll
    for (int i = 0; i < 4; ++i) vcur[i] = vr[i];
    sgu_load_v(vr, a, next_item, tid);
    {
        const int tl = tid >> 2, q4 = tid & 3;
        float x[32];
#pragma unroll
        for (int i = 0; i < 4; ++i) {
#pragma unroll
            for (int e = 0; e < 4; ++e) { x[8 * i + 2 * e] = bflo(vcur[i][e]); x[8 * i + 2 * e + 1] = bfhi(vcur[i][e]); } }
        float s = 0.f;
#pragma unroll
        for (int e = 0; e < 32; ++e) s += x[e];
        s = DPP_ADD(s, 0xB1); s = DPP_ADD(s, 0x4E);
        const float mean = s * (1.f / 128.f); float q = 0.f;
#pragma unroll
        for (int e = 0; e < 32; ++e) { x[e] -= mean; q += x[e] * x[e]; }
        q = DPP_ADD(q, 0xB1); q = DPP_ADD(q, 0x4E);
        const float rstd = __builtin_amdgcn_rsqf(q * (1.f / 128.f) + EPS);
        const f32x4* gl = (const f32x4*)(a->in[9] + g * 128 + q4 * 32);
#pragma unroll
        for (int e4 = 0; e4 < 8; ++e4) { const f32x4 gv = gl[e4];
#pragma unroll
            for (int e = 0; e < 4; ++e) vnT[(q4 * 32 + 4 * e4 + e) * SG_LDW + tl] = (bf16)pk2(x[4 * e4 + e] * rstd * gv[e], 0.f); }
    }
    bf16x8 bw[8];
    {   const float* wrow = a->in[10] + ((size_t)g * 128 + t) * 128 + 8 * hi;
#pragma unroll
        for (int ks = 0; ks < 8; ++ks) { v4u w = (v4u){0u, 0u, 0u, 0u};
            if (ks < nks) { const f32x4 w0 = *(const f32x4*)(wrow + ks * 16), w1 = *(const f32x4*)(wrow + ks * 16 + 4);
                float f[8] = {w0[0], w0[1], w0[2], w0[3], w1[0], w1[1], w1[2], w1[3]};
                if (ks >= nks - 2) { const int nkeep = t - (ks * 16 + 8 * hi) + 1;
#pragma unroll
                    for (int e = 0; e < 8; ++e) f[e] = (e < nkeep) ? f[e] : 0.f; }
                w.x = pk2(f[0], f[1]); w.y = pk2(f[2], f[3]); w.z = pk2(f[4], f[5]); w.w = pk2(f[6], f[7]); }
            bw[ks] = __builtin_bit_cast(bf16x8, w); } }
    __syncthreads();
    f32x16 acc[2];
#pragma unroll
    for (int ct = 0; ct < 2; ++ct) { acc[ct] = (f32x16){};
#pragma unroll
        for (int ks = 0; ks < 8; ++ks) if (ks < nks) {
            const bf16x8 av = *(const LAS bf16x8*)(vnT + (chh * 64 + ct * 32 + j) * SG_LDW + ks * 16 + 8 * hi);
            acc[ct] = __builtin_amdgcn_mfma_f32_32x32x16_bf16(av, bw[ks], acc[ct], 0, 0, 0); } }
    bf16* op = cat + (size_t)(tok0 + t) * DM + 1024 + g * 128 + chh * 64 + 4 * hi;
#pragma unroll
    for (int ct = 0; ct < 2; ++ct)
#pragma unroll
        for (int rg = 0; rg < 4; ++rg) { const v2u u2 = uu[ct][rg];
            const float o0 = bflo(u2.x) * (acc[ct][4 * rg] + bs), o1 = bfhi(u2.x) * (acc[ct][4 * rg + 1] + bs), o2 = bflo(u2.y) * (acc[ct][4 * rg + 2] + bs), o3 = bfhi(u2.y) * (acc[ct][4 * rg + 3] + bs);
            v2u w; w.x = pk2(o0, o1); w.y = pk2(o2, o3); *(v2u*)(op + ct * 32 + 8 * rg) = w; }
    __syncthreads();
}
__device__ __forceinline__ void bias2_gemv(LAS unsigned char* lds, KA a, int g0, int gstep) {
    {   int tid = threadIdx.x; asm volatile("" : "+v"(tid)); const int lane = tid & 63, wave = __builtin_amdgcn_readfirstlane(tid >> 6);
        LAS float* shl = (LAS float*)lds; LAS float* red = (LAS float*)(lds + 65536);
        const float* mod = (const float*)(a->ws + WS_MOD); const float* W1 = a->in[14]; float* bias2 = (float*)(a->ws + WS_BIAS2);
        for (int i = tid; i < 8 * DM / 4; i += 512) { const int b = i >> 9, j4 = i & 511; *(LAS f32x4*)(shl + b * DM + j4 * 4) = *(const f32x4*)(mod + b * NMODC + 3 * DM + j4 * 4); }
        __syncthreads();
        for (int grp = g0; grp < DFF / 32; grp += gstep) {
            const int n = grp * 32 + (lane & 31), kp = lane >> 5; const float* wp = W1 + (size_t)(wave * 256 + kp) * DFF + n;
            float ab[8];
#pragma unroll
            for (int b = 0; b < 8; ++b) ab[b] = 0.f;
#pragma unroll 1
            for (int k0 = 0; k0 < 256; k0 += 32) { float w[16];
#pragma unroll
                for (int i = 0; i < 16; ++i) w[i] = __builtin_nontemporal_load(wp + (size_t)(k0 + 2 * i) * DFF);
#pragma unroll
                for (int i = 0; i < 16; ++i)
#pragma unroll
                    for (int b = 0; b < 8; ++b) ab[b] += w[i] * shl[b * DM + wave * 256 + k0 + 2 * i + kp]; }
#pragma unroll
            for (int b = 0; b < 8; ++b) { ab[b] += __shfl_xor(ab[b], 32); if (lane < 32) red[(wave * 8 + b) * 32 + lane] = ab[b]; }
            __syncthreads();
            if (tid < 256) { const int b = tid >> 5, nn = tid & 31; float z = 0.f;
#pragma unroll
                for (int w = 0; w < 8; ++w) z += red[(w * 8 + b) * 32 + nn];
                bias2[b * DFF + grp * 32 + nn] = z; }
            __syncthreads(); }
    }
}
#ifdef PROBE_PHASE
#define PSTAMP(k) do { if (blockIdx.x == 0) ((unsigned long long*)(a->ws + WS_TS))[k] = __builtin_amdgcn_s_memrealtime(); } while (0)
#else
#define PSTAMP(k) do { } while (0)
#endif
__device__ __forceinline__ void p4_phase(unsigned char* ldsg, LAS unsigned char* lds, KA a) {
    typedef __hip_bfloat16 hb;
    const hb* proj = (const hb*)(a->ws + WS_PROJ); hb* cat = (hb*)(a->ws + WS_CAT); const float* LS = (const float*)(a->ws + WS_LS);
    PSTAMP(10);
    { int G = gridDim.x, bx = blockIdx.x; asm volatile("" : "+s"(G), "+s"(bx)); const int vcu = (G % 8 == 0) ? (bx % 8) * (G / 8) + bx / 8 : bx;
    for (int L = vcu; L < BATCH * NH * 4; L += G) {
        int tid = threadIdx.x; asm volatile("" : "+v"(tid)); const int lane = tid & 63, wave = __builtin_amdgcn_readfirstlane(tid >> 6);
        const int bh = L >> 2, x = L & 3, b = bh >> 3, h = bh & 7;
        __syncthreads();
        {
            LAS float* Gl = (LAS float*)(lds + att::GL_OFF); LAS float* wsum = (LAS float*)(lds + att::GL_OFF + 8192);
            const float* lp = LS + ((size_t)b * SEQ + tid * 4) * 8 + h;
            float v0 = lp[0], v1 = lp[8], v2 = lp[16], v3 = lp[24];
            v1 += v0; v2 += v1; v3 += v2;
            float s = v3;
#pragma unroll
            for (int o = 1; o < 64; o <<= 1) { const float tt = __shfl_up(s, o); if (lane >= o) s += tt; }
            if (lane == 63) wsum[wave] = s;
            __syncthreads();
            float base = s - v3;
            for (int w = 0; w < wave; ++w) base += wsum[w];
            const float KS = -11.313708498984761f;
            *(LAS f32x4*)(Gl + tid * 4) = (f32x4){(base + v0) * KS, (base + v1) * KS, (base + v2) * KS, (base + v3) * KS};
        }
        __syncthreads();
        att::BlockRef<hb, hb> blk[2];
#pragma unroll
        for (int p = 0; p < 2; ++p) { blk[p].B = proj + (size_t)b * SEQ * NP + h * 128; blk[p].OB = cat + (size_t)b * SEQ * DM + h * 128; blk[p].P0 = (p ? 7 - x : x) * 256; }
        att::Seam<hb> S;
        att::causal_swa_prime<hb, hb>(blk[0], 1 << 30, (char*)ldsg, S);
        att::causal_swa_block<hb, hb>(blk[0], blk[1], SEQ, 1 << 30, (char*)ldsg, S);
        att::causal_swa_block<hb, hb>(blk[1], blk[1], SEQ, 1 << 30, (char*)ldsg, S);
    }
    }
    __syncthreads();
    PSTAMP(11);
    { PHASE_IDS(); constexpr int NSG = BATCH * 16 * NGRP;
      if (vcu < NSG) { v4u vr[4]; sgu_load_v(vr, a, vcu, tid);
          for (int it = vcu; it < NSG; it += G) sgu_item(lds, a, it, it + G < NSG ? it + G : it, vr, tid, lane, wave); } }
    PSTAMP(12);
}

#define XB_TMO      128
#define XB_XCNT(j)  (256  + 64 * (j))
#define XB_XSUB(j)  (1280 + 64 * (j))
#define XB_XGEN(j)  (2304 + 64 * (j))
#define XB_TOP      3328
#define XB_TOPGEN   3392
#define XCD_BAR_WORDS 3456
#define XB_SPIN_CAP (1u << 18)

__device__ __forceinline__ unsigned xb_ld(unsigned* p)              { return __hip_atomic_load(p, __ATOMIC_RELAXED, __HIP_MEMORY_SCOPE_AGENT); }
__device__ __forceinline__ unsigned xb_add(unsigned* p, unsigned v) { return __hip_atomic_fetch_add(p, v, __ATOMIC_RELAXED, __HIP_MEMORY_SCOPE_AGENT); }
__device__ __forceinline__ unsigned xb_xcc_id() { return (unsigned)__builtin_amdgcn_s_getreg((3 << 11) | 20) & 0xFu; }
#define XB_SPIN(cond, bar) do { unsigned _sp = 0; while (cond) { __builtin_amdgcn_s_sleep(1); \
    if ((++_sp & 255u) == 0u) { if (xb_ld(&(bar)[XB_TMO])) break; if (_sp > XB_SPIN_CAP) { atomicAdd(&(bar)[XB_TMO], 1u); break; } } } } while (0)

struct XcdBarrier {
    unsigned* bar; unsigned x;
    volatile LAS unsigned* st;
};

__device__ __forceinline__ XcdBarrier xcd_barrier_post(unsigned* bar, volatile LAS unsigned* st) {
    XcdBarrier b; b.bar = bar; b.x = xb_xcc_id(); b.st = st;
    if (threadIdx.x == 0) (void)xb_add(&bar[XB_XCNT(b.x)], 1u);
    return b;
}
__device__ __forceinline__ void xcd_barrier_complete(unsigned* bar, unsigned x, unsigned& nloc, unsigned& nx) {
    const unsigned G = gridDim.x * gridDim.y * gridDim.z;
    unsigned sum, cnt, mine, sp = 0u;
    for (;;) {
        sum = 0u; cnt = 0u; mine = 0u;
#pragma unroll
        for (unsigned j = 0; j < 16; ++j) { const unsigned c = xb_ld(&bar[XB_XCNT(j)]); sum += c; cnt += (c > 0u) ? 1u : 0u; mine = (j == x) ? c : mine; }
        if (sum == G) break;
        __builtin_amdgcn_s_sleep(1);
        if ((++sp & 255u) == 0u) { if (xb_ld(&bar[XB_TMO])) break; if (sp > XB_SPIN_CAP) { atomicAdd(&bar[XB_TMO], 1u); break; } }
    }
    nloc = mine > 0u ? mine : 1u; nx = cnt > 0u ? cnt : 1u;
}

__device__ __forceinline__ void xcd_barrier(const XcdBarrier& b) {
    asm volatile("s_waitcnt vmcnt(0)" ::: "memory");
    __syncthreads();
    if (threadIdx.x == 0) {
        unsigned* bar = b.bar;
        __builtin_amdgcn_s_waitcnt(0);
        unsigned nloc = b.st[0], nx = b.st[1];
        if (nloc == 0u) { xcd_barrier_complete(bar, b.x, nloc, nx); b.st[0] = nloc; b.st[1] = nx; }
        const unsigned old = xb_add(&bar[XB_XSUB(b.x)], 1u);
        const unsigned gen = old / nloc;
        if (old + 1u == (gen + 1u) * nloc) {
            __builtin_amdgcn_fence(__ATOMIC_RELEASE, "agent");
            asm volatile("s_waitcnt vmcnt(0)" ::: "memory");
            const unsigned og = xb_add(&bar[XB_TOP], 1u);
            const unsigned tg = og / nx;
            if (og + 1u == (tg + 1u) * nx) xb_add(&bar[XB_TOPGEN], 1u);
            else XB_SPIN(xb_ld(&bar[XB_TOPGEN]) == tg, bar);
            __builtin_amdgcn_fence(__ATOMIC_ACQUIRE, "agent");
            xb_add(&bar[XB_XGEN(b.x)], 1u);
            asm volatile("s_waitcnt vmcnt(0)" ::: "memory");
        } else {
            XB_SPIN(xb_ld(&bar[XB_XGEN(b.x)]) == gen, bar);
            __builtin_amdgcn_fence(__ATOMIC_ACQUIRE, "agent");
            asm volatile("s_waitcnt vmcnt(0)" ::: "memory");
        }
    }
    __syncthreads();
}

__global__ void __launch_bounds__(NWAVES * 64, 2) fwd_kernel(Args a_by_value) {
    KA a = (KA)__builtin_amdgcn_kernarg_segment_ptr();
    extern __shared__ __attribute__((aligned(16))) unsigned char lds_raw[];
    LAS unsigned char* lds = (LAS unsigned char*)lds_raw;
    const int lo = a->ph_lo, hi = a->ph_hi;
#ifdef ONLY_PHASE
#define IN(k) ((k) == ONLY_PHASE && lo <= (k) && (k) < hi)
#else
#define IN(k) (lo <= (k) && (k) < hi)
#endif
#ifdef PROBE_PHASE
#define STAMP(k) do { if (blockIdx.x == 0) ((unsigned long long*)(a->ws + WS_TS))[k] = __builtin_amdgcn_s_memrealtime(); } while (0)
#else
#define STAMP(k) do { } while (0)
#endif
    if (threadIdx.x < 2) ((volatile LAS unsigned*)(lds + XB_LDS_OFF))[threadIdx.x] = 0u;
    __syncthreads();
    const XcdBarrier xbar = xcd_barrier_post((unsigned*)(a->ws + WS_BAR), (volatile LAS unsigned*)(lds + XB_LDS_OFF));
    if (lo < 0) cg::this_grid().sync();
#define SEAM(k) do { if (IN(k) && IN((k) + 1)) { xcd_barrier(xbar); } STAMP((k) + 1); } while (0)
    STAMP(0);
    if (IN(0)) { p0_phase(lds, a); } SEAM(0);
    if (IN(1)) { p1_phase(lds, a); } SEAM(1);
    if (IN(2)) { PHASE_IDS(); unsigned char* ws = a->ws;
        pg8::Gemm g{(const bf16*)(ws + WS_H), (const bf16*)(ws + WS_WIN), M, NP, DM}; pg8::StaticOrder S; S.init(M, NP, G, bx, 4);
        pg8::EpiProj E{(bf16*)(ws + WS_PROJ), NP, 12, (LAS float*)(lds + RING_BYTES), a->in[7], a->in[8], EPS};
        if (vcu & 1) { bias2_gemv(lds, a, vcu, G); __syncthreads(); }
        pg8::gemm_phase<pg8::EpiProj, pg8::StaticOrder, true, true>(lds, g, S, E);
        if (!(vcu & 1)) { __syncthreads(); bias2_gemv(lds, a, vcu, G); }
    } SEAM(2);
    if (IN(3)) { p4_phase(lds_raw, lds, a); } SEAM(3);
    if (IN(4)) { PHASE_IDS(); unsigned char* ws = a->ws;
        {
            constexpr int F2_0 = (DM / 64) * (NP / 64) + (DM / 64) * (DM / 64) + (DM / 64) * (DFF / 64), F2_N = (DFF / 64) * (DM / 64);
            const int nodd = G / 2; LAS float* scr = (LAS float*)(lds + wave * 16640);
            if (nodd == 0) { const int i0 = wave; t_run(a, scr, F2_0 + i0, NWAVES, (F2_N - i0 + NWAVES - 1) / NWAVES, lane); }
            else if (vcu & 1) { const int i0 = (vcu >> 1) * NWAVES + wave, st = nodd * NWAVES; if (i0 < F2_N) t_run(a, scr, F2_0 + i0, st, (F2_N - i0 + st - 1) / st, lane); }
            __syncthreads();
        }
        pg8::Gemm g{(const bf16*)(ws + WS_CAT), (const bf16*)(ws + WS_WOUT), M, DM, DM}; pg8::StaticOrder S; S.init(M, DM, G, bx, 4);
        pg8::EpiRes<true> E{a->in[0], nullptr, nullptr, (bf16*)(ws + WS_X1B), DM, (const float*)(ws + WS_MOD) + 2 * DM, NMODC, (bf16*)(ws + WS_H), a->in[13], (const float*)(ws + WS_MOD) + 4 * DM, (float*)(ws + WS_ROWSS)};
        pg8::gemm_phase<pg8::EpiRes<true>, pg8::StaticOrder, true, true>(lds, g, S, E);
        {
            constexpr int F1_0 = (DM / 64) * (NP / 64) + (DM / 64) * (DM / 64), F1_N = (DM / 64) * (DFF / 64);
            const int neven = (G + 1) / 2; LAS float* scr = (LAS float*)(lds + wave * 16640);
            __syncthreads();
            if (!(vcu & 1)) { const int i0 = (vcu >> 1) * NWAVES + wave, st = neven * NWAVES; if (i0 < F1_N) t_run(a, scr, F1_0 + i0, st, (F1_N - i0 + st - 1) / st, lane); }
        }
    } SEAM(4);
    if (IN(5)) { PHASE_IDS(); unsigned char* ws = a->ws;
        pg8::Gemm g{(const bf16*)(ws + WS_H), (const bf16*)(ws + WS_WFF1), M, DFF, DM}; pg8::StaticOrder S; S.init(M, DFF, G, bx, 4);
        pg8::EpiFF1 E{(bf16*)(ws + WS_A), DFF, (const float*)(ws + WS_ROWSS), (const float*)(ws + WS_BIAS2), DFF, 1.f / DM, EPS};
        pg8::gemm_phase<pg8::EpiFF1, pg8::StaticOrder, true, true>(lds, g, S, E);
    } SEAM(5);
    if (IN(6)) { PHASE_IDS(); unsigned char* ws = a->ws;
        pg8::Gemm g{(const bf16*)(ws + WS_A), (const bf16*)(ws + WS_WFF2), M, DM, DFF}; pg8::StaticOrder S; S.init(M, DM, G, bx, 4, 1);
        pg8::EpiRes<false> E{nullptr, (const bf16*)(ws + WS_X1B), a->out, nullptr, DM, (const float*)(ws + WS_MOD) + 5 * DM, NMODC, nullptr, nullptr, nullptr, nullptr};
        pg8::gemm_phase<pg8::EpiRes<false>, pg8::StaticOrder, true, true>(lds, g, S, E);
    }
#ifdef PROBE_PHASE
    xcd_barrier(xbar); STAMP(NPHASE);
    if (blockIdx.x == 0) { const unsigned long long* ts = (const unsigned long long*)(a->ws + WS_TS);
        const float us = (float)(ts[PROBE_END] - ts[PROBE_PHASE]) * 0.01f;
        const float us2 = (float)(ts[PROBE_END2] - ts[PROBE_PHASE2]) * 0.01f;
        if (threadIdx.x == 0) a->out[12345] += us * PROBE_SCALE;
        const float d2 = sqrtf(us2) * 0.0078125f;
        for (int i = threadIdx.x; i < 65536; i += 512) a->out[(1 << 20) + i] += d2; }
#endif
#undef IN
#undef SEAM
}

extern "C" void kernel_launch(void* const* d_in, const int* in_sizes, int n_in, void* d_out, int out_size, void* d_ws, size_t ws_size, hipStream_t stream) {
    static int grid = 0;
    if (grid == 0) {
        if (n_in != 16 || in_sizes[0] != M * DM || out_size != M * DM || ws_size < WS_END) { fprintf(stderr, "kernel_launch: unexpected shapes (n_in %d, in0 %d, out %d, ws %zu)\n", n_in, n_in > 0 ? in_sizes[0] : -1, out_size, ws_size); grid = -1; return; }
        int dev = 0, cus = 0, per_cu = 0;
        if (hipGetDevice(&dev) != hipSuccess || hipDeviceGetAttribute(&cus, hipDeviceAttributeMultiprocessorCount, dev) != hipSuccess) { grid = -1; return; }
        if (hipFuncSetAttribute((const void*)fwd_kernel, hipFuncAttributeMaxDynamicSharedMemorySize, LDS_BYTES) != hipSuccess) { fprintf(stderr, "kernel_launch: hipFuncSetAttribute failed\n"); grid = -1; return; }
        if (hipOccupancyMaxActiveBlocksPerMultiprocessor(&per_cu, (const void*)fwd_kernel, NWAVES * 64, LDS_BYTES) != hipSuccess || per_cu < 1) { fprintf(stderr, "kernel_launch: occupancy query says %d\n", per_cu); (void)hipGetLastError(); per_cu = 1; }
        if (per_cu > 1) per_cu = 1;
        grid = cus * per_cu;
    }
    if (grid < 0) return;
    if (hipMemsetAsync((char*)d_ws + WS_BAR, 0, WS_BAR_BYTES, stream) != hipSuccess) { fprintf(stderr, "kernel_launch: hipMemsetAsync failed\n"); return; }
    Args a{};
    for (int i = 0; i < 16; ++i) a.in[i] = (const float*)d_in[i];
    a.out = (float*)d_out; a.ws = (unsigned char*)d_ws;
#if MK_PER_PHASE
    for (int p = 0; p < NPHASE; ++p) { a.ph_lo = p; a.ph_hi = p + 1; hipLaunchKernelGGL(fwd_kernel, dim3(grid), dim3(NWAVES * 64), LDS_BYTES, stream, a); }
#else
    a.ph_lo = 0; a.ph_hi = NPHASE;
    void* args[] = {&a};
    hipError_t e = hipLaunchCooperativeKernel((const void*)fwd_kernel, dim3(grid), dim3(NWAVES * 64), args, LDS_BYTES, stream);
    if (e != hipSuccess) fprintf(stderr, "kernel_launch: cooperative launch failed: %s (grid %d)\n", hipGetErrorString(e), grid);
#endif
}
```
